# Optimizing an MI355X kernel written in HIP

```python
import math
import jax, jax.numpy as jnp
from jax import lax
import numpy as np

D_MODEL = 1024
BATCH = 4
SEQ = 8192
DEPTH = 1
DEC_BATCH = 8
DEC_SEQ = 2048
PAST_LEN = 128

D_MIX = D_MODEL
HY_WIDTH = D_MIX // 2
HY_STREAMS = 3
SHORT_CONV = 3
FILT_BANDS = 16
FILT_EMB = 1 + 2 * FILT_BANDS
FILT_HIDDEN = 64
DECAY_TARGET = 1e-2
FAST_DECAY_PCT = 0.3
SLOW_DECAY_PCT = 1.5
N_HEADS = 8
QK_NOPE = 64
QK_ROPE = 32
QK_DIM = QK_NOPE + QK_ROPE
V_DIM = 64
MLA_WIDTH = N_HEADS * V_DIM
Q_LORA = 256
KV_LORA = 128
ROPE_THETA = 10000.0
Q_BLOCK = 128
D_FF = 4 * D_MODEL
PLE_DIM = 256
EPS = 1e-6
IN_COLS = HY_STREAMS * HY_WIDTH + Q_LORA + KV_LORA + QK_ROPE

kernel_name = "hymba_hyena_mla_encoder"

F32 = jnp.float32


def _rmsnorm(x, w):
    x32 = x.astype(F32)
    y = x32 * lax.rsqrt(jnp.mean(x32 * x32, axis=-1, keepdims=True) + EPS)
    return (y * w.astype(F32)).astype(x.dtype)


def _short_conv(u, w, b):
    L = u.shape[1]
    pad = SHORT_CONV // 2
    up = jnp.pad(u, ((0, 0), (pad, SHORT_CONV - 1 - pad), (0, 0)))
    out = b
    for j in range(SHORT_CONV):
        out = out + up[:, j:j + L] * w[j]
    return out


def _hyena_filters(L, filt_w1, filt_b1, filt_freq, filt_w2, filt_b2, filt_w3):
    t = jnp.linspace(0.0, 1.0, L, dtype=F32)[:, None]
    w = (2.0 * math.pi) * jnp.arange(L, dtype=F32)[:, None] / L
    f = jnp.linspace(1e-4, FILT_BANDS - 1, FILT_BANDS, dtype=F32)[None, :]
    z = jnp.concatenate([t, jnp.cos(f * w), -jnp.sin(f * w)], axis=-1)
    freq = filt_freq.astype(F32)
    h = jnp.sin(freq * (z @ filt_w1.astype(F32) + filt_b1.astype(F32)))
    h = jnp.sin(freq * (h @ filt_w2.astype(F32) + filt_b2.astype(F32)))
    h = h @ filt_w3.astype(F32)
    min_decay = math.log(DECAY_TARGET) / FAST_DECAY_PCT
    max_decay = math.log(DECAY_TARGET) / SLOW_DECAY_PCT
    deltas = jnp.abs(jnp.linspace(min_decay, max_decay, HY_WIDTH, dtype=F32))
    decay = jnp.exp(-t * deltas)
    return h[:, :HY_WIDTH] * decay, h[:, HY_WIDTH:] * decay


def _hyena(hy, conv_w, conv_b, filt_w1, filt_b1, filt_freq, filt_w2, filt_b2, filt_w3, filt_bias):
    L = hy.shape[1]
    u = _short_conv(hy, conv_w, conv_b)
    x0, x1, v = jnp.split(u, HY_STREAMS, axis=-1)
    h_fwd, h_bwd = _hyena_filters(L, filt_w1, filt_b1, filt_freq, filt_w2, filt_b2, filt_w3)
    kern = jnp.concatenate([h_fwd, h_bwd[::-1]], axis=0)
    kf = jnp.fft.rfft(kern, axis=0)
    z = (v * x1).astype(F32)
    zf = jnp.fft.rfft(z, n=2 * L, axis=1)
    y = jnp.fft.irfft(zf * kf[None], n=2 * L, axis=1)[:, :L] + z * filt_bias.astype(F32)
    return (x0.astype(F32) * y).astype(hy.dtype)


def _rope(x, L):
    half = QK_ROPE // 2
    inv = ROPE_THETA ** (-(2.0 * jnp.arange(half, dtype=F32)) / QK_ROPE)
    ang = jnp.arange(L, dtype=F32)[:, None] * inv[None, :]
    cos = jnp.cos(ang)[None, :, None, :]
    sin = jnp.sin(ang)[None, :, None, :]
    x32 = x.astype(F32)
    a, b = x32[..., :half], x32[..., half:]
    return jnp.concatenate([a * cos - b * sin, a * sin + b * cos], axis=-1).astype(x.dtype)


def _mla(q_lat, kv_lat, k_rope, q_a_norm_w, w_q_b, kv_a_norm_w, w_kv_b, q_norm_w, k_norm_w):
    B, L = q_lat.shape[0], q_lat.shape[1]
    q = (_rmsnorm(q_lat, q_a_norm_w) @ w_q_b).reshape(B, L, N_HEADS, QK_DIM)
    kv = (_rmsnorm(kv_lat, kv_a_norm_w) @ w_kv_b).reshape(B, L, N_HEADS, QK_NOPE + V_DIM)
    k_nope, v = kv[..., :QK_NOPE], kv[..., QK_NOPE:]
    k = jnp.concatenate([k_nope, jnp.broadcast_to(k_rope[:, :, None, :], (B, L, N_HEADS, QK_ROPE))], axis=-1)
    q = _rmsnorm(q, q_norm_w)
    k = _rmsnorm(k, k_norm_w)
    q = jnp.concatenate([q[..., :QK_NOPE], _rope(q[..., QK_NOPE:], L)], axis=-1)
    k = jnp.concatenate([k[..., :QK_NOPE], _rope(k[..., QK_NOPE:], L)], axis=-1)
    nb = L // Q_BLOCK
    qb = q.reshape(B, nb, Q_BLOCK, N_HEADS, QK_DIM).transpose(1, 0, 2, 3, 4)
    scale = QK_DIM ** -0.5

    def attend(qi):
        s = jnp.einsum('bqhd,bkhd->bhqk', qi, k, preferred_element_type=F32) * scale
        p = jax.nn.softmax(s, axis=-1)
        return jnp.einsum('bhqk,bkhv->bqhv', p.astype(v.dtype), v)

    o = lax.map(attend, qb)
    return o.transpose(1, 0, 2, 3, 4).reshape(B, L, MLA_WIDTH)


def _layer(x, p_l, attn_norm_w, w_in, conv_w, conv_b, filt_w1, filt_b1, filt_freq, filt_w2,
           filt_b2, filt_w3, filt_bias, q_a_norm_w, w_q_b, kv_a_norm_w, w_kv_b, q_norm_w,
           k_norm_w, hy_out_norm_w, mla_out_norm_w, w_out, mlp_norm_w, w_mlp1, w_mlp2,
           w_ple_gate, w_ple_proj, ple_norm_w):
    xn = _rmsnorm(x, attn_norm_w)
    proj = xn @ w_in
    o1 = HY_STREAMS * HY_WIDTH
    o2 = o1 + Q_LORA
    o3 = o2 + KV_LORA
    hy, q_lat, kv_lat, k_rope = proj[..., :o1], proj[..., o1:o2], proj[..., o2:o3], proj[..., o3:]
    y_hy = _hyena(hy, conv_w, conv_b, filt_w1, filt_b1, filt_freq, filt_w2, filt_b2, filt_w3, filt_bias)
    y_mla = _mla(q_lat, kv_lat, k_rope, q_a_norm_w, w_q_b, kv_a_norm_w, w_kv_b, q_norm_w, k_norm_w)
    mix = jnp.concatenate([_rmsnorm(y_hy, hy_out_norm_w), _rmsnorm(y_mla, mla_out_norm_w)], axis=-1)
    x = x + mix @ w_out
    h = _rmsnorm(x, mlp_norm_w) @ w_mlp1
    x = x + jnp.square(jax.nn.relu(h)) @ w_mlp2
    gate = jax.nn.sigmoid(x @ w_ple_gate)
    x = x + gate * _rmsnorm(p_l @ w_ple_proj, ple_norm_w)
    return x


def _trunk(x, p, attn_norm_w, w_in, conv_w, conv_b, filt_w1, filt_b1, filt_freq, filt_w2,
           filt_b2, filt_w3, filt_bias, q_a_norm_w, w_q_b, kv_a_norm_w, w_kv_b, q_norm_w,
           k_norm_w, hy_out_norm_w, mla_out_norm_w, w_out, mlp_norm_w, w_mlp1, w_mlp2,
           w_ple_gate, w_ple_proj, ple_norm_w):
    for i in range(DEPTH):
        x = _layer(x, p[i], attn_norm_w[i], w_in[i], conv_w[i], conv_b[i], filt_w1[i], filt_b1[i],
                   filt_freq[i], filt_w2[i], filt_b2[i], filt_w3[i], filt_bias[i], q_a_norm_w[i],
                   w_q_b[i], kv_a_norm_w[i], w_kv_b[i], q_norm_w[i], k_norm_w[i], hy_out_norm_w[i],
                   mla_out_norm_w[i], w_out[i], mlp_norm_w[i], w_mlp1[i], w_mlp2[i], w_ple_gate[i],
                   w_ple_proj[i], ple_norm_w[i])
    return x


def setup_inputs(seed: int = 0) -> dict:
    key = jax.random.key(seed)
    ks = jax.random.split(key, 40)

    def nrm(k, shape, scale=1.0):
        return jax.random.normal(k, shape, dtype=F32) * scale

    def gain(k, n):
        return 1.0 + 0.02 * jax.random.normal(k, (DEPTH, n), dtype=F32)

    return {
        "x_prompt": nrm(ks[0], (BATCH, SEQ, D_MODEL)),
        "x_sample": nrm(ks[1], (DEC_BATCH, DEC_SEQ, D_MODEL)),
        "p_prompt": nrm(ks[2], (DEPTH, BATCH, SEQ, PLE_DIM)),
        "p_sample": nrm(ks[3], (DEPTH, DEC_BATCH, DEC_SEQ, PLE_DIM)),
        "attn_norm_w": gain(ks[4], D_MODEL),
        "w_in": nrm(ks[5], (DEPTH, D_MODEL, IN_COLS), D_MODEL ** -0.5),
        "conv_w": nrm(ks[6], (DEPTH, SHORT_CONV, HY_STREAMS * HY_WIDTH), SHORT_CONV ** -0.5),
        "conv_b": nrm(ks[7], (DEPTH, HY_STREAMS * HY_WIDTH), 0.02),
        "filt_w1": nrm(ks[8], (DEPTH, FILT_EMB, FILT_HIDDEN), FILT_EMB ** -0.5),
        "filt_b1": nrm(ks[9], (DEPTH, FILT_HIDDEN), 0.02),
        "filt_freq": gain(ks[10], FILT_HIDDEN),
        "filt_w2": nrm(ks[11], (DEPTH, FILT_HIDDEN, FILT_HIDDEN), FILT_HIDDEN ** -0.5),
        "filt_b2": nrm(ks[12], (DEPTH, FILT_HIDDEN), 0.02),
        "filt_w3": nrm(ks[13], (DEPTH, FILT_HIDDEN, 2 * HY_WIDTH), FILT_HIDDEN ** -0.5),
        "filt_bias": nrm(ks[14], (DEPTH, HY_WIDTH), 0.5),
        "q_a_norm_w": gain(ks[15], Q_LORA),
        "w_q_b": nrm(ks[16], (DEPTH, Q_LORA, N_HEADS * QK_DIM), Q_LORA ** -0.5),
        "kv_a_norm_w": gain(ks[17], KV_LORA),
        "w_kv_b": nrm(ks[18], (DEPTH, KV_LORA, N_HEADS * (QK_NOPE + V_DIM)), KV_LORA ** -0.5),
        "q_norm_w": gain(ks[19], QK_DIM),
        "k_norm_w": gain(ks[20], QK_DIM),
        "hy_out_norm_w": gain(ks[21], HY_WIDTH),
        "mla_out_norm_w": gain(ks[22], MLA_WIDTH),
        "w_out": nrm(ks[23], (DEPTH, HY_WIDTH + MLA_WIDTH, D_MODEL), (HY_WIDTH + MLA_WIDTH) ** -0.5),
        "mlp_norm_w": gain(ks[24], D_MODEL),
        "w_mlp1": nrm(ks[25], (DEPTH, D_MODEL, D_FF), D_MODEL ** -0.5),
        "w_mlp2": nrm(ks[26], (DEPTH, D_FF, D_MODEL), D_FF ** -0.5),
        "w_ple_gate": nrm(ks[27], (DEPTH, D_MODEL, D_MODEL), D_MODEL ** -0.5),
        "w_ple_proj": nrm(ks[28], (DEPTH, PLE_DIM, D_MODEL), PLE_DIM ** -0.5),
        "ple_norm_w": gain(ks[29], D_MODEL),
    }


def reference(x_prompt, x_sample, p_prompt, p_sample, attn_norm_w, w_in, conv_w, conv_b,
              filt_w1, filt_b1, filt_freq, filt_w2, filt_b2, filt_w3, filt_bias, q_a_norm_w,
              w_q_b, kv_a_norm_w, w_kv_b, q_norm_w, k_norm_w, hy_out_norm_w, mla_out_norm_w,
              w_out, mlp_norm_w, w_mlp1, w_mlp2, w_ple_gate, w_ple_proj, ple_norm_w):
    y_prompt = _trunk(x_prompt, p_prompt, attn_norm_w, w_in, conv_w, conv_b, filt_w1, filt_b1,
                      filt_freq, filt_w2, filt_b2, filt_w3, filt_bias, q_a_norm_w, w_q_b,
                      kv_a_norm_w, w_kv_b, q_norm_w, k_norm_w, hy_out_norm_w, mla_out_norm_w,
                      w_out, mlp_norm_w, w_mlp1, w_mlp2, w_ple_gate, w_ple_proj, ple_norm_w)
    y_sample = _trunk(x_sample, p_sample, attn_norm_w, w_in, conv_w, conv_b, filt_w1, filt_b1,
                      filt_freq, filt_w2, filt_b2, filt_w3, filt_bias, q_a_norm_w, w_q_b,
                      kv_a_norm_w, w_kv_b, q_norm_w, k_norm_w, hy_out_norm_w, mla_out_norm_w,
                      w_out, mlp_norm_w, w_mlp1, w_mlp2, w_ple_gate, w_ple_proj, ple_norm_w)
    return (y_prompt, y_sample)
```

```cpp
#include <hip/hip_runtime.h>
#include <hip/hip_cooperative_groups.h>
#include <cstdio>
#include <cstdint>
namespace cg = cooperative_groups;
#define ATTN_REP 1
#define ATT_SCHED 0
#ifndef MK_COOP
#define MK_COOP 1
#endif
#ifndef MK_XCDBAR
#define MK_XCDBAR 1
#endif
namespace pg8 {
#define PG8_LAS __attribute__((address_space(3)))
typedef unsigned short bf16_t;
typedef short bf16x8 __attribute__((ext_vector_type(8)));
typedef float f32x4 __attribute__((ext_vector_type(4)));
typedef unsigned u32x4 __attribute__((ext_vector_type(4)));
constexpr int BM = 256, BK = 64, HALF = 128, HTB = HALF * BK * 2  , STAGE_BYTES = 8 * HTB, NXCD = 8, WGM = 8;

__host__ __device__ __forceinline__ int lds_byte(int r, int c) { const int st = (r >> 4) * 2 + (c >> 5), rr = r & 15, cc = c & 31, ob = rr * 64 + cc * 2; return st * 1024 + (ob ^ (((ob >> 9) & 1) << 5)); }
__host__ __device__ __forceinline__ void stage_rc(int b, int& R, int& C) { const int st = b / 1024, sb = b % 1024, swz = sb ^ (((sb >> 9) & 1) << 5); R = (st >> 1) * 16 + swz / 64; C = (st & 1) * 32 + (swz % 64) / 2; }
__host__ __device__ __forceinline__ int perm32(int rho) { const int n = rho >> 4, i = rho & 15; return 8 * (i >> 2) + 4 * n + (i & 3); }

struct Unit { int pm, pn; };
struct Gemm { const bf16_t* A; const bf16_t* Bt; int M, N, K; };

struct StaticOrder {
    int nM, nN, nwg, G, c;
    __host__ __device__ void init(int M, int N, int G_, int c_) { nM = M / BM; nN = N / BM; nwg = nM * nN; G = G_; c = c_; }
    __host__ __device__ bool next(int i, Unit& u) const {
        const long L = (long)i * G + c; if (L >= nwg) return false;
        int wgid = (int)L; { const int q = nwg / NXCD, r = nwg % NXCD, xcd = wgid % NXCD, off = wgid / NXCD; wgid = (xcd < r ? xcd * (q + 1) : r * (q + 1) + (xcd - r) * q) + off; }
        const int nig = WGM * nN, gid = wgid / nig, fm = gid * WGM, gsz = (nM - fm) < WGM ? (nM - fm) : WGM;
        u.pm = fm + ((wgid % nig) % gsz); u.pn = (wgid % nig) / gsz; return true;
    }
    __device__ __forceinline__ void a_ready(const Unit&) const {}
    __device__ __forceinline__ void done(const Unit&) const {}
};

__device__ __forceinline__ unsigned cvt_pk_bf16(float lo, float hi) { unsigned r; asm volatile("v_cvt_pk_bf16_f32 %0, %1, %2" : "=v"(r) : "v"(lo), "v"(hi)); return r; }
typedef float f32x2 __attribute__((ext_vector_type(2)));
template <class Epi, class Sched, bool ALIGN_EPI = false, bool SP2 = false>
__device__ __forceinline__ void gemm_phase(PG8_LAS unsigned char* lds, const Gemm g, const Sched& S, const Epi& E) {
    const int tid = threadIdx.x, wid = __builtin_amdgcn_readfirstlane(tid >> 6), lane = tid & 63, wr = wid >> 2, wc = wid & 3, fr = lane & 15, fq = lane >> 4;
    const int K = g.K, nt = K / BK;
    unsigned voffA[2], voffB[2];
#pragma unroll
    for (int i = 0; i < 2; ++i) { int R, C; stage_rc(tid * 16 + i * 8192, R, C); const int Rb = Epi::PERM ? ((R & ~31) + perm32(R & 31)) : R;
        voffA[i] = (unsigned)(R * K + C) * 2u; voffB[i] = (unsigned)(Rb * K + C) * 2u; }
    const size_t kstep = (size_t)(BK * 2);
    const size_t hstep = (size_t)HALF * K * 2;
    const size_t tstep = 2 * hstep;
    const unsigned ldsw = (unsigned)wid * 1024u;
    const int aoff = lds_byte(wr * 64 + fr, fq * 8), boff = lds_byte(wc * 32 + fr, fq * 8);
#define PG8_SA(b, h) (((b) * 2 + (h)) * HTB)
#define PG8_SB(b, h) ((4 + (b) * 2 + (h)) * HTB)
#define PG8_STAGE(bufoff, gbase, voff) do { _Pragma("unroll") for (int _i = 0; _i < 2; ++_i) \
        __builtin_amdgcn_global_load_lds((const unsigned*)((const char*)(gbase) + (voff)[_i]), (PG8_LAS unsigned*)(lds + (bufoff) + ldsw + _i * 8192), 16, 0, 0); } while (0)
#define PG8_LDA(dst, b, h) do { _Pragma("unroll") for (int m = 0; m < 4; ++m) _Pragma("unroll") for (int k = 0; k < 2; ++k) dst[m][k] = *(const PG8_LAS bf16x8*)(lds + PG8_SA(b, h) + aoff + m * 2048 + k * 1024); } while (0)
#define PG8_LDB(dst, b, h) do { _Pragma("unroll") for (int n = 0; n < 2; ++n) _Pragma("unroll") for (int k = 0; k < 2; ++k) dst[n][k] = *(const PG8_LAS bf16x8*)(lds + PG8_SB(b, h) + boff + n * 2048 + k * 1024); } while (0)
#define PG8_MMA(ai, bj, At, Bt) do { __builtin_amdgcn_s_setprio(1); _Pragma("unroll") for (int m = 0; m < 4; ++m) _Pragma("unroll") for (int n = 0; n < 2; ++n) _Pragma("unroll") for (int k = 0; k < 2; ++k) \
        acc[ai][bj][m][n] = __builtin_amdgcn_mfma_f32_16x16x32_bf16(Bt[n][k], At[m][k], acc[ai][bj][m][n], 0, 0, 0); __builtin_amdgcn_s_setprio(0); } while (0)
#define PG8_WAIT_V(n) asm volatile("s_waitcnt vmcnt(" #n ")" ::: "memory")
#define PG8_WAIT_L(n) asm volatile("s_waitcnt lgkmcnt(" #n ")" ::: "memory")
#define PG8_BAR __builtin_amdgcn_s_barrier()
#define PG8_SCHED __builtin_amdgcn_sched_barrier(0)
    Unit cur, nxt; int ui = 0;
    if (!S.next(0, cur)) return;
    f32x4 acc[2][2][4][2];
#pragma unroll
    for (int a = 0; a < 2; ++a)
#pragma unroll
        for (int b = 0; b < 2; ++b)
#pragma unroll
            for (int m = 0; m < 4; ++m)
#pragma unroll
                for (int n = 0; n < 2; ++n) acc[a][b][m][n] = (f32x4){0.f, 0.f, 0.f, 0.f};
    bf16x8 At[4][2], B0[2][2], B1[2][2];
    const char* cA = (const char*)g.A + (size_t)cur.pm * tstep; const char* cB = (const char*)g.Bt + (size_t)cur.pn * tstep;
    S.a_ready(cur);
    if constexpr (SP2) {
        PG8_STAGE(PG8_SB(0, 0), cB, voffB); PG8_STAGE(PG8_SB(0, 1), cB + hstep, voffB); PG8_STAGE(PG8_SA(0, 0), cA, voffA); PG8_STAGE(PG8_SA(0, 1), cA + hstep, voffA);
        if (wr == 1) PG8_BAR;
        PG8_WAIT_V(2); PG8_BAR;
        PG8_STAGE(PG8_SB(1, 0), cB + kstep, voffB); PG8_STAGE(PG8_SA(1, 0), cA + kstep, voffA); PG8_STAGE(PG8_SB(1, 1), cB + hstep + kstep, voffB);
        PG8_WAIT_V(6); PG8_BAR;
    } else {
        PG8_STAGE(PG8_SB(0, 0), cB, voffB); PG8_STAGE(PG8_SA(0, 0), cA, voffA); PG8_STAGE(PG8_SB(0, 1), cB + hstep, voffB); PG8_STAGE(PG8_SA(0, 1), cA + hstep, voffA);
        if (wr == 1) PG8_BAR;
        PG8_WAIT_V(4); PG8_BAR;
        PG8_STAGE(PG8_SB(1, 0), cB + kstep, voffB); PG8_STAGE(PG8_SA(1, 0), cA + kstep, voffA); PG8_STAGE(PG8_SB(1, 1), cB + hstep + kstep, voffB);
        PG8_WAIT_V(6); PG8_BAR;
    }
    for (;;) {
        const bool has_next = S.next(ui + 1, nxt);
        const char* nA = has_next ? (const char*)g.A + (size_t)nxt.pm * tstep : cA; const char* nB = has_next ? (const char*)g.Bt + (size_t)nxt.pn * tstep : cB;
        for (int t = 0; t < nt; t += 2) {
            const bool last = (t == nt - 2);
            const char* a1 = cA + (size_t)(t + 1) * kstep;
            const char* a2 = last ? nA : cA + (size_t)(t + 2) * kstep; const char* b2 = last ? nB : cB + (size_t)(t + 2) * kstep;
            const char* a3 = a2 + kstep; const char* b3 = b2 + kstep;
            if (last && has_next) S.a_ready(nxt);
            if constexpr (SP2) {
            PG8_LDB(B0, 0, 0); PG8_LDB(B1, 0, 1); PG8_SCHED; PG8_LDA(At, 0, 0); PG8_STAGE(PG8_SA(1, 1), a1 + hstep, voffA);
            PG8_WAIT_V(8); PG8_WAIT_L(0); PG8_BAR; PG8_MMA(0, 0, At, B0); PG8_MMA(0, 1, At, B1); PG8_BAR; PG8_SCHED;
            PG8_LDA(At, 0, 1); PG8_STAGE(PG8_SB(0, 0), b2, voffB); PG8_STAGE(PG8_SB(0, 1), b2 + hstep, voffB); PG8_STAGE(PG8_SA(0, 0), a2, voffA);
            PG8_WAIT_V(8); PG8_WAIT_L(0); PG8_BAR; PG8_MMA(1, 0, At, B0); PG8_MMA(1, 1, At, B1); PG8_BAR; PG8_SCHED;
            PG8_LDB(B0, 1, 0); PG8_LDB(B1, 1, 1); PG8_SCHED; PG8_LDA(At, 1, 0); PG8_STAGE(PG8_SA(0, 1), a2 + hstep, voffA);
            PG8_WAIT_V(8); PG8_WAIT_L(0); PG8_BAR; PG8_MMA(0, 0, At, B0); PG8_MMA(0, 1, At, B1); PG8_BAR; PG8_SCHED;
            PG8_LDA(At, 1, 1); PG8_STAGE(PG8_SB(1, 0), b3, voffB); PG8_STAGE(PG8_SB(1, 1), b3 + hstep, voffB); PG8_STAGE(PG8_SA(1, 0), a3, voffA);
            PG8_WAIT_V(8); PG8_WAIT_L(0); PG8_BAR; PG8_MMA(1, 0, At, B0); PG8_MMA(1, 1, At, B1); PG8_BAR; PG8_SCHED;
            } else {
            PG8_LDB(B0, 0, 0); PG8_SCHED; PG8_LDA(At, 0, 0); PG8_STAGE(PG8_SA(1, 1), a1 + hstep, voffA);
            PG8_WAIT_L(8); PG8_BAR; PG8_WAIT_L(0); PG8_MMA(0, 0, At, B0); PG8_BAR; PG8_SCHED;
            PG8_LDB(B1, 0, 1); PG8_STAGE(PG8_SB(0, 0), b2, voffB);
            PG8_BAR; PG8_WAIT_L(0); PG8_MMA(0, 1, At, B1); PG8_BAR;
            PG8_LDA(At, 0, 1); PG8_STAGE(PG8_SA(0, 0), a2, voffA);
            PG8_BAR; PG8_WAIT_L(0); PG8_MMA(1, 0, At, B0); PG8_BAR; PG8_SCHED;
            PG8_STAGE(PG8_SB(0, 1), b2 + hstep, voffB);
            PG8_WAIT_V(6); PG8_BAR; PG8_MMA(1, 1, At, B1); PG8_BAR;
            PG8_LDB(B0, 1, 0); PG8_SCHED; PG8_LDA(At, 1, 0); PG8_STAGE(PG8_SA(0, 1), a2 + hstep, voffA);
            PG8_WAIT_L(8); PG8_BAR; PG8_WAIT_L(0); PG8_MMA(0, 0, At, B0); PG8_BAR; PG8_SCHED;
            PG8_LDB(B1, 1, 1); PG8_STAGE(PG8_SB(1, 0), b3, voffB);
            PG8_BAR; PG8_WAIT_L(0); PG8_MMA(0, 1, At, B1); PG8_BAR;
            PG8_LDA(At, 1, 1); PG8_STAGE(PG8_SA(1, 0), a3, voffA);
            PG8_BAR; PG8_WAIT_L(0); PG8_MMA(1, 0, At, B0); PG8_BAR; PG8_SCHED;
            PG8_STAGE(PG8_SB(1, 1), b3 + hstep, voffB);
            PG8_WAIT_V(6); PG8_BAR; PG8_MMA(1, 1, At, B1); PG8_BAR;
            }
        }
        if constexpr (ALIGN_EPI) { if (wr == 0) PG8_BAR; }
        if constexpr (!Epi::AFTER_DRAIN) { E(acc, cur, wr, wc, fr, fq); S.done(cur); }
        if (!has_next) break;
#pragma unroll
        for (int a = 0; a < 2; ++a)
#pragma unroll
            for (int b = 0; b < 2; ++b)
#pragma unroll
                for (int m = 0; m < 4; ++m)
#pragma unroll
                    for (int n = 0; n < 2; ++n) acc[a][b][m][n] = (f32x4){0.f, 0.f, 0.f, 0.f};
        cur = nxt; cA = nA; cB = nB; ++ui;
        if constexpr (ALIGN_EPI) { if (wr == 1) PG8_BAR; }
    }
    PG8_WAIT_V(0);
    if constexpr (!ALIGN_EPI) { if (wr == 0) PG8_BAR; }
    PG8_BAR;
    if constexpr (Epi::AFTER_DRAIN) { E.fused(acc, cur, wr, wc, fr, fq, lds, wid, lane); S.done(cur); }
#undef PG8_SA
#undef PG8_SB
#undef PG8_STAGE
#undef PG8_LDA
#undef PG8_LDB
#undef PG8_MMA
#undef PG8_WAIT_V
#undef PG8_WAIT_L
#undef PG8_BAR
#undef PG8_SCHED
}
}
namespace pg8 {
typedef unsigned u32x2 __attribute__((ext_vector_type(2)));
constexpr float RMS_EPS = 1e-6f;
struct EpiScaleBf16 {
    static constexpr bool PERM = true, AFTER_DRAIN = false;
    bf16_t* O; int ldc; const float* rstd;
    __device__ __forceinline__ void operator()(const f32x4 (&acc)[2][2][4][2], const Unit& u, int wr, int wc, int fr, int fq) const {
        const int row0 = u.pm * BM + wr * 64 + fr, col0 = u.pn * BM + wc * 32 + 8 * fq;
#pragma unroll
        for (int ai = 0; ai < 2; ++ai)
#pragma unroll
            for (int m = 0; m < 4; ++m) { const int row = row0 + ai * HALF + m * 16; const float s = rstd[row]; bf16_t* rowp = O + (size_t)row * ldc + col0;
#pragma unroll
                for (int bj = 0; bj < 2; ++bj) { const f32x4 v0 = acc[ai][bj][m][0] * s, v1 = acc[ai][bj][m][1] * s; u32x4 w;
                    w.x = cvt_pk_bf16(v0[0], v0[1]); w.y = cvt_pk_bf16(v0[2], v0[3]); w.z = cvt_pk_bf16(v1[0], v1[1]); w.w = cvt_pk_bf16(v1[2], v1[3]);
                    *(u32x4*)(rowp + bj * HALF) = w; } }
    }
};
struct EpiRelu2Bf16 {
    static constexpr bool PERM = true, AFTER_DRAIN = false;
    bf16_t* O; int ldc; const float* rowss; int row_off;
    __device__ __forceinline__ void operator()(const f32x4 (&acc)[2][2][4][2], const Unit& u, int wr, int wc, int fr, int fq) const {
        const int row0 = u.pm * BM + wr * 64 + fr, col0 = u.pn * BM + wc * 32 + 8 * fq;
#pragma unroll
        for (int ai = 0; ai < 2; ++ai)
#pragma unroll
            for (int m = 0; m < 4; ++m) { const int row = row0 + ai * HALF + m * 16; const float s = __builtin_amdgcn_rsqf(rowss[row_off + row] * (1.0f / 1024.0f) + RMS_EPS); bf16_t* rowp = O + (size_t)row * ldc + col0;
#pragma unroll
                for (int bj = 0; bj < 2; ++bj) { f32x4 v0 = acc[ai][bj][m][0] * s, v1 = acc[ai][bj][m][1] * s;
#pragma unroll
                    for (int e = 0; e < 4; ++e) { const float a = fmaxf(v0[e], 0.f), b = fmaxf(v1[e], 0.f); v0[e] = a * a; v1[e] = b * b; }
                    u32x4 w; w.x = cvt_pk_bf16(v0[0], v0[1]); w.y = cvt_pk_bf16(v0[2], v0[3]); w.z = cvt_pk_bf16(v1[0], v1[1]); w.w = cvt_pk_bf16(v1[2], v1[3]);
                    *(u32x4*)(rowp + bj * HALF) = w; } }
    }
};
struct EpiResF32 {
    static constexpr bool PERM = false, AFTER_DRAIN = false;
    const float* r0; const float* r1; int split; float* out; bf16_t* ob; float* rowss; int row_off;
    __device__ __forceinline__ void operator()(const f32x4 (&acc)[2][2][4][2], const Unit& u, int wr, int wc, int fr, int fq) const {
        const int col0 = u.pn * BM + wc * 32 + 4 * fq;
#pragma unroll
        for (int ai = 0; ai < 2; ++ai) {
            f32x4 pre[4][2][2];
#pragma unroll
            for (int m = 0; m < 4; ++m) { const int row = row_off + u.pm * BM + ai * HALF + wr * 64 + m * 16 + fr;
                const float* rr = (row < split) ? r0 + (size_t)row * 1024 : r1 + (size_t)(row - split) * 1024;
#pragma unroll
                for (int bj = 0; bj < 2; ++bj)
#pragma unroll
                    for (int n = 0; n < 2; ++n) pre[m][bj][n] = *(const f32x4*)(rr + col0 + bj * HALF + n * 16); }
            asm volatile("" ::: "memory");
#pragma unroll
            for (int m = 0; m < 4; ++m) { const int row = row_off + u.pm * BM + ai * HALF + wr * 64 + m * 16 + fr; float ss = 0.f;
#pragma unroll
                for (int bj = 0; bj < 2; ++bj)
#pragma unroll
                    for (int n = 0; n < 2; ++n) { const int col = col0 + bj * HALF + n * 16; const f32x4 v = pre[m][bj][n] + acc[ai][bj][m][n];
                        *(f32x4*)(out + (size_t)row * 1024 + col) = v; u32x2 w; w.x = cvt_pk_bf16(v[0], v[1]); w.y = cvt_pk_bf16(v[2], v[3]); *(u32x2*)(ob + (size_t)row * 1024 + col) = w;
                        ss += (v[0] * v[0] + v[1] * v[1]) + (v[2] * v[2] + v[3] * v[3]); }
                if (rowss) { ss += __shfl_xor(ss, 16); ss += __shfl_xor(ss, 32); if (fq == 0) atomicAdd(rowss + row, ss); } }
        }
    }
};
struct EpiResBf16 {
    static constexpr bool PERM = false, AFTER_DRAIN = false;
    const float* r0; const float* r1; int split; const bf16_t* rb; bf16_t* ob; float* rowss; int row_off;
    __device__ __forceinline__ void operator()(const f32x4 (&acc)[2][2][4][2], const Unit& u, int wr, int wc, int fr, int fq) const {
        const int col0 = u.pn * BM + wc * 32 + 4 * fq;
#pragma unroll
        for (int ai = 0; ai < 2; ++ai) {
            f32x4 pre[4][2][2];
#pragma unroll
            for (int m = 0; m < 4; ++m) { const int row = row_off + u.pm * BM + ai * HALF + wr * 64 + m * 16 + fr;
                if (rb) {
#pragma unroll
                    for (int bj = 0; bj < 2; ++bj)
#pragma unroll
                        for (int n = 0; n < 2; ++n) { const u32x2 w = *(const u32x2*)(rb + (size_t)row * 1024 + col0 + bj * HALF + n * 16);
                            pre[m][bj][n] = (f32x4){__uint_as_float(w.x << 16), __uint_as_float(w.x & 0xffff0000u), __uint_as_float(w.y << 16), __uint_as_float(w.y & 0xffff0000u)}; }
                } else { const float* rr = (row < split) ? r0 + (size_t)row * 1024 : r1 + (size_t)(row - split) * 1024;
#pragma unroll
                    for (int bj = 0; bj < 2; ++bj)
#pragma unroll
                        for (int n = 0; n < 2; ++n) pre[m][bj][n] = *(const f32x4*)(rr + col0 + bj * HALF + n * 16); } }
            asm volatile("" ::: "memory");
#pragma unroll
            for (int m = 0; m < 4; ++m) { const int row = row_off + u.pm * BM + ai * HALF + wr * 64 + m * 16 + fr; float ss = 0.f;
#pragma unroll
                for (int bj = 0; bj < 2; ++bj)
#pragma unroll
                    for (int n = 0; n < 2; ++n) { const int col = col0 + bj * HALF + n * 16; const f32x4 v = pre[m][bj][n] + acc[ai][bj][m][n];
                        u32x2 w; w.x = cvt_pk_bf16(v[0], v[1]); w.y = cvt_pk_bf16(v[2], v[3]); *(u32x2*)(ob + (size_t)row * 1024 + col) = w;
                        ss += (v[0] * v[0] + v[1] * v[1]) + (v[2] * v[2] + v[3] * v[3]); }
                if (rowss) { ss += __shfl_xor(ss, 16); ss += __shfl_xor(ss, 32); if (fq == 0) atomicAdd(rowss + row, ss); } }
        }
    }
};
struct EpiBf16Ss {
    static constexpr bool PERM = true, AFTER_DRAIN = false;
    bf16_t* O; int ldc; float* rowss;
    __device__ __forceinline__ void operator()(const f32x4 (&acc)[2][2][4][2], const Unit& u, int wr, int wc, int fr, int fq) const {
        const int row0 = u.pm * BM + wr * 64 + fr, col0 = u.pn * BM + wc * 32 + 8 * fq;
#pragma unroll
        for (int ai = 0; ai < 2; ++ai)
#pragma unroll
            for (int m = 0; m < 4; ++m) { const int row = row0 + ai * HALF + m * 16; bf16_t* rowp = O + (size_t)row * ldc + col0; float ss = 0.f;
#pragma unroll
                for (int bj = 0; bj < 2; ++bj) { const f32x4 v0 = acc[ai][bj][m][0], v1 = acc[ai][bj][m][1]; u32x4 w;
                    w.x = cvt_pk_bf16(v0[0], v0[1]); w.y = cvt_pk_bf16(v0[2], v0[3]); w.z = cvt_pk_bf16(v1[0], v1[1]); w.w = cvt_pk_bf16(v1[2], v1[3]);
                    *(u32x4*)(rowp + bj * HALF) = w;
                    ss += (v0[0] * v0[0] + v0[1] * v0[1]) + (v0[2] * v0[2] + v0[3] * v0[3]) + (v1[0] * v1[0] + v1[1] * v1[1]) + (v1[2] * v1[2] + v1[3] * v1[3]); }
                ss += __shfl_xor(ss, 16); ss += __shfl_xor(ss, 32); if (fq == 0) atomicAdd(rowss + row, ss); }
    }
};
struct EpiFinal {
    static constexpr bool PERM = false, AFTER_DRAIN = false;
    float* out; const bf16_t* xr; const bf16_t* pp; const float* rowssp; const float* pw;
    __device__ __forceinline__ void operator()(const f32x4 (&acc)[2][2][4][2], const Unit& u, int wr, int wc, int fr, int fq) const {
        const int col0 = u.pn * BM + wc * 32 + 4 * fq;
#pragma unroll
        for (int ai = 0; ai < 2; ++ai)
#pragma unroll
            for (int m = 0; m < 4; ++m) { const int row = u.pm * BM + ai * HALF + wr * 64 + m * 16 + fr; const float s = __builtin_amdgcn_rsqf(rowssp[row] * (1.0f / 1024.0f) + RMS_EPS);
#pragma unroll
                for (int bj = 0; bj < 2; ++bj)
#pragma unroll
                    for (int n = 0; n < 2; ++n) { const int col = col0 + bj * HALF + n * 16; const size_t off = (size_t)row * 1024 + col;
                        const u32x2 xw = *(const u32x2*)(xr + off); const f32x4 x = (f32x4){__uint_as_float(xw.x << 16), __uint_as_float(xw.x & 0xffff0000u), __uint_as_float(xw.y << 16), __uint_as_float(xw.y & 0xffff0000u)}; const f32x4 w = *(const f32x4*)(pw + col); const u32x2 pb = *(const u32x2*)(pp + off); const f32x4 g = acc[ai][bj][m][n];
                        f32x4 p; p[0] = __uint_as_float(pb.x << 16); p[1] = __uint_as_float(pb.x & 0xffff0000u); p[2] = __uint_as_float(pb.y << 16); p[3] = __uint_as_float(pb.y & 0xffff0000u);
                        f32x4 o;
#pragma unroll
                        for (int e = 0; e < 4; ++e) { const float sg = 1.0f / (1.0f + __expf(-g[e])); o[e] = x[e] + sg * p[e] * s * w[e]; }
                        *(f32x4*)(out + off) = o; } }
    }
};
}
#define GAS __attribute__((address_space(1)))
#define LAS __attribute__((address_space(3)))
typedef unsigned short bf16;
typedef float f32x4 __attribute__((ext_vector_type(4)));
typedef float f32x16 __attribute__((ext_vector_type(16)));
typedef short bf16x8 __attribute__((ext_vector_type(8)));
typedef short s16x4 __attribute__((ext_vector_type(4)));
typedef unsigned u32x4 __attribute__((ext_vector_type(4)));
typedef unsigned u32x2 __attribute__((ext_vector_type(2)));
constexpr int DM = 1024, LP = 8192, BP = 4, LS = 2048, BS = 8, MP = BP * LP, MS = BS * LS, MT = MP + MS;
constexpr int NIN = 2048, IN_COLS = 1952, HYW = 512, QLORA = 256, KVLORA = 128, NH = 8, QKD = 96, DFF = 4096, PLE = 256;
constexpr int COL_Q = 1536, COL_KV = 1792, COL_KR = 1920;
constexpr float EPS = 1e-6f;
constexpr float QSCALE = 0.10206207261596575f * 1.4426950408889634f;
constexpr int NWAVES = 8, NTHR = 512;
constexpr int KVT_BYTES = 20480, KT_BYTES = 12288;
constexpr size_t QS_OFF = (size_t)32 * LP * QKD;
constexpr size_t KVS_OFF = (size_t)32 * (LP / 64) * KVT_BYTES;
constexpr size_t MiB = 1u << 20;
constexpr size_t WS_CTL = 0, CTL_ZERO_BYTES = 1 * MiB;
constexpr size_t WS_ROWSS1 = 256 * 1024, WS_ROWSSP = 512 * 1024;
constexpr size_t WS_RSTD0 = 1 * MiB, WS_TW = 1 * MiB + 256 * 1024, WS_ROPE = 2 * MiB, WS_H2P = 3 * MiB, WS_H2S = 5 * MiB + 512 * 1024;
constexpr size_t WS_WIN = 8 * MiB, WS_WQB = 12 * MiB, WS_WKVB = 12 * MiB + 512 * 1024, WS_WOUT = 13 * MiB, WS_W1 = 15 * MiB, WS_W2 = 23 * MiB, WS_WG = 31 * MiB, WS_WPP = 33 * MiB;
constexpr size_t WS_PB = 34 * MiB;
constexpr size_t WS_A = 58 * MiB;
constexpr size_t WS_B = 154 * MiB;
constexpr size_t WS_YMLA = WS_B, WS_MIX = WS_B + 96 * MiB, WS_KSPEC = WS_MIX, WS_HMID = WS_B, WS_PP = WS_B + 128 * MiB;
constexpr size_t WS_C = 346 * MiB;
constexpr size_t WS_KERNP = 466 * MiB, WS_KERNS = 498 * MiB;
constexpr size_t WS_END = 506 * MiB;
constexpr int CW_BAR = 4096;
static_assert((16384 + 16384 / 16) * 8 <= 131072 + 8192 && 4 * (4096 + 4096 / 16) * 8 <= 131072 + 8192, "padded FFT image must end below the LDS control words");
constexpr int RING_BYTES = 131072, LDSX_OFF = RING_BYTES  , LDSCTL_OFF = RING_BYTES + 8192, MISC_OFF = LDSCTL_OFF + 320, LDS_BYTES = 147456;

#define LDS_WAIT() asm volatile("s_waitcnt lgkmcnt(0)" ::: "memory")
#define VM_WAIT() asm volatile("s_waitcnt vmcnt(0)" ::: "memory")
__device__ __forceinline__ unsigned f2bf(float f) { unsigned u = __builtin_bit_cast(unsigned, f); return (u + 0x7fffu + ((u >> 16) & 1u)) >> 16; }
__device__ __forceinline__ unsigned pk2(float lo, float hi) { return f2bf(lo) | (f2bf(hi) << 16); }
__device__ __forceinline__ float bf2f(unsigned h) { return __uint_as_float(h << 16); }
__device__ __forceinline__ float wave_sum(float v) {
#pragma unroll
    for (int o = 1; o < 64; o <<= 1) v += __shfl_xor(v, o);
    return v;
}
__device__ __forceinline__ int crow(int r, int hi) { return (r & 3) + 8 * (r >> 2) + 4 * hi; }
__device__ __forceinline__ float fadd_s(float a, float b) { float r; asm("v_add_f32_e32 %0, %1, %2" : "=v"(r) : "v"(a), "v"(b)); return r; }
__device__ __forceinline__ float fsub_s(float a, float b) { float r; asm("v_sub_f32_e32 %0, %1, %2" : "=v"(r) : "v"(a), "v"(b)); return r; }
__device__ __forceinline__ float fmul_s(float a, float b) { float r; asm("v_mul_f32_e32 %0, %1, %2" : "=v"(r) : "v"(a), "v"(b)); return r; }
__device__ __forceinline__ float ffma_s(float a, float b, float c) { float r; asm("v_fma_f32 %0, %1, %2, %3" : "=v"(r) : "v"(a), "v"(b), "v"(c)); return r; }
__device__ __forceinline__ float ffms_s(float a, float b, float c) { float r; asm("v_fma_f32 %0, %1, %2, -%3" : "=v"(r) : "v"(a), "v"(b), "v"(c)); return r; }

struct Args { const float* in[30]; float* out; unsigned char* ws; int ph_lo, ph_hi; };
struct Frame {
    unsigned char* lds;
    int wave, vcu, G;
    const float* in[30]; float* out; unsigned char* ws;
};
__device__ __forceinline__ const float* xrow(const Frame& F, int m) { return m < MP ? F.in[0] + (size_t)m * DM : F.in[1] + (size_t)(m - MP) * DM; }
__device__ __forceinline__ const float* prow(const Frame& F, int m) { return m < MP ? F.in[2] + (size_t)m * PLE : F.in[3] + (size_t)(m - MP) * PLE; }

__device__ __forceinline__ void p0_transpose_item(const float* W, int K, int N, bf16* WT, const float* sc, float* scr, int item, int lane, int R = 0) {
    const int nblk = N / 32, kb = item / nblk, nb = item % nblk, k0 = 64 * kb, n0 = 32 * nb;
#pragma unroll
    for (int i = 0; i < 32; ++i) { const int kk = 2 * i + (lane >> 5); float v = W[(size_t)(k0 + kk) * N + n0 + (lane & 31)]; if (sc) v *= sc[k0 + kk]; scr[kk * 33 + (lane & 31)] = v; }
    LDS_WAIT(); asm volatile("" ::: "memory");
    const int c = lane & 7;
#pragma unroll
    for (int j = 0; j < 4; ++j) { const int n = (lane >> 3) + 8 * j; const float* s = scr + (8 * c) * 33 + n;
        u32x4 o; o.x = pk2(s[0 * 33], s[1 * 33]); o.y = pk2(s[2 * 33], s[3 * 33]); o.z = pk2(s[4 * 33], s[5 * 33]); o.w = pk2(s[6 * 33], s[7 * 33]);
        if (R == 0) *(u32x4*)(WT + (size_t)(n0 + n) * K + k0 + 8 * c) = o;
        else { const int nn = n0 + n, h = nn / R, ft = (nn % R) >> 5, r32 = nn & 31, kc = (k0 >> 3) + c, ks = kc >> 1, hh = kc & 1, nks = K >> 4;
            *(u32x4*)(WT + ((size_t)(((h * (R >> 5) + ft) * nks + ks) * 64 + hh * 32 + r32)) * 8) = o; } }
    LDS_WAIT(); asm volatile("" ::: "memory");
}
__device__ __forceinline__ void p0_prologue(Frame& F) {
    float* scr = (float*)(F.lds + F.wave * 16384);
    const int gw = F.vcu * NWAVES + F.wave, NGW = F.G * NWAVES, lane = ((int)threadIdx.x & 63);
    unsigned char* ws = F.ws;
    constexpr int I_IN = 16 * 61, I_QB = 4 * 24, I_KVB = 2 * 32, I_OUT = 16 * 32, I_1 = 16 * 128, I_2 = 64 * 32, I_G = 16 * 32, I_PP = 4 * 32;
    constexpr int NITEMS = I_IN + I_QB + I_KVB + I_OUT + I_1 + I_2 + I_G + I_PP;
    for (int it = gw; it < NITEMS; it += NGW) {
        int r = it;
        if (r < I_IN) { p0_transpose_item(F.in[5], 1024, IN_COLS, (bf16*)(ws + WS_WIN), F.in[4], scr, r, lane); continue; } r -= I_IN;
        if (r < I_QB) { p0_transpose_item(F.in[16], QLORA, 768, (bf16*)(ws + WS_WQB), F.in[15], scr, r, lane, QKD); continue; } r -= I_QB;
        if (r < I_KVB) { p0_transpose_item(F.in[18], KVLORA, 1024, (bf16*)(ws + WS_WKVB), F.in[17], scr, r, lane, 128); continue; } r -= I_KVB;
        if (r < I_OUT) { p0_transpose_item(F.in[23], 1024, 1024, (bf16*)(ws + WS_WOUT), nullptr, scr, r, lane); continue; } r -= I_OUT;
        if (r < I_1) { p0_transpose_item(F.in[25], 1024, DFF, (bf16*)(ws + WS_W1), F.in[24], scr, r, lane); continue; } r -= I_1;
        if (r < I_2) { p0_transpose_item(F.in[26], DFF, 1024, (bf16*)(ws + WS_W2), nullptr, scr, r, lane); continue; } r -= I_2;
        if (r < I_G) { p0_transpose_item(F.in[27], 1024, 1024, (bf16*)(ws + WS_WG), nullptr, scr, r, lane); continue; } r -= I_G;
        p0_transpose_item(F.in[28], PLE, 1024, (bf16*)(ws + WS_WPP), nullptr, scr, r, lane);
    }
    { u32x4* z = (u32x4*)(ws + WS_WIN + (size_t)IN_COLS * 1024 * 2); const int n16 = (NIN - IN_COLS) * 1024 * 2 / 16;
      for (int i = (F.vcu * NTHR + ((int)threadIdx.x)); i < n16; i += F.G * NTHR) z[i] = (u32x4){0u, 0u, 0u, 0u}; }
    bf16* xb = (bf16*)(ws + WS_A); float* rstd0 = (float*)(ws + WS_RSTD0); bf16* pb = (bf16*)(ws + WS_PB);
#pragma unroll 8
    for (int m = gw; m < MT; m += NGW) {
        const f32x4* xr = (const f32x4*)xrow(F, m) + lane; f32x4 v[4]; float s = 0.f;
#pragma unroll
        for (int j = 0; j < 4; ++j) { v[j] = xr[64 * j]; s += (v[j].x * v[j].x + v[j].y * v[j].y) + (v[j].z * v[j].z + v[j].w * v[j].w); }
        s = wave_sum(s);
        if (lane == 0) rstd0[m] = 1.0f / sqrtf(s * (1.0f / DM) + EPS);
        u32x2* o8 = (u32x2*)(xb + (size_t)m * DM) + lane;
#pragma unroll
        for (int j = 0; j < 4; ++j) { u32x2 w; w.x = pk2(v[j].x, v[j].y); w.y = pk2(v[j].z, v[j].w); o8[64 * j] = w; }
        const f32x4 pv = ((const f32x4*)prow(F, m))[lane]; u32x2 w; w.x = pk2(pv.x, pv.y); w.y = pk2(pv.z, pv.w); ((u32x2*)(pb + (size_t)m * PLE))[lane] = w;
    }
    { float2* tw = (float2*)(ws + WS_TW); float2* rope = (float2*)(ws + WS_ROPE);
      for (int i = F.vcu * NTHR + ((int)threadIdx.x); i < 16384; i += F.G * NTHR) { float sn, cs; sincospif((float)i * (1.0f / 8192.0f), &sn, &cs); tw[i] = make_float2(cs, -sn); }
      for (int i = F.vcu * NTHR + ((int)threadIdx.x); i < LP * 16; i += F.G * NTHR) { const int t = i >> 4, k = i & 15; const float inv = powf(10000.0f, -(2.0f * (float)k) / 32.0f); const float ang = (float)t * inv;
          float sn, cs; sincosf(ang, &sn, &cs); rope[i] = make_float2(cs, sn); } }
    { const float* w1 = F.in[8]; const float* b1 = F.in[9]; const float* fq = F.in[10]; const float* w2 = F.in[11]; const float* b2 = F.in[12];
      const float freq = fq[lane], bb1 = b1[lane], bb2 = b2[lane];
      for (int pos = gw; pos < LP + LS; pos += NGW) {
          const int L = pos < LP ? LP : LS, j = pos < LP ? pos : pos - LP;
          const float t = (float)j * (1.0f / (float)(L - 1)); const float w = (6.283185307179586f * (float)j) / (float)L;
          float zv = 0.f;
          if (lane == 0) zv = t;
          else if (lane <= 16) { const float f = 1e-4f + (float)(lane - 1) * ((15.0f - 1e-4f) / 15.0f); zv = cosf(f * w); }
          else if (lane <= 32) { const float f = 1e-4f + (float)(lane - 17) * ((15.0f - 1e-4f) / 15.0f); zv = -sinf(f * w); }
          float a1 = bb1;
          for (int i = 0; i < 33; ++i) a1 += __shfl(zv, i) * w1[i * 64 + lane];
          const float h1 = sinf(freq * a1);
          float a2 = bb2;
          for (int k = 0; k < 64; ++k) a2 += __shfl(h1, k) * w2[k * 64 + lane];
          const float h2 = sinf(freq * a2);
          float* dst = (pos < LP) ? (float*)(ws + WS_H2P) + (size_t)lane * LP + j : (float*)(ws + WS_H2S) + (size_t)lane * LS + j;
          *dst = h2;
      } }
}

__device__ __forceinline__ void p2_mla_tile(Frame& F, int tile) {
    const int lane = ((int)threadIdx.x & 63), wid = F.wave, r32 = lane & 31, hi = lane >> 5;
    unsigned char* lds = F.lds;
    unsigned char* LQ = lds; unsigned char* LKV = lds + 32768; unsigned char* LKR = lds + 49152; float* RS = (float*)(lds + 53248);
    const bf16* proj = (const bf16*)(F.ws + WS_B);
    const int m0 = tile * 64;
#pragma unroll 2
    for (int i = 0; i < 8; ++i) { const int tok = wid * 8 + i; float ss = 0.f;
        if (lane < 52) { const u32x4 v = *(const u32x4*)(proj + (size_t)(m0 + tok) * NIN + COL_Q + lane * 8);
            const unsigned w[4] = {v.x, v.y, v.z, v.w};
#pragma unroll
            for (int e = 0; e < 4; ++e) { const float a = __uint_as_float(w[e] << 16), b = __uint_as_float(w[e] & 0xffff0000u); ss += a * a + b * b; }
            unsigned char* dst = lane < 32 ? LQ + (lane * 64 + tok) * 16 : (lane < 48 ? LKV + ((lane - 32) * 64 + tok) * 16 : LKR + tok * 64 + (lane - 48) * 16);
            *(u32x4*)dst = v; }
        const float sq = wave_sum(lane < 32 ? ss : 0.f), skv = wave_sum((lane >= 32 && lane < 48) ? ss : 0.f);
        if (lane == 0) { RS[tok] = 1.0f / sqrtf(sq * (1.0f / QLORA) + EPS); RS[64 + tok] = 1.0f / sqrtf(skv * (1.0f / KVLORA) + EPS); } }
    __syncthreads();
    int b, t0, L; size_t qoff; size_t kvoff;
    if (m0 < MP) { b = m0 / LP; t0 = m0 % LP; L = LP; qoff = ((size_t)(b * NH + wid) * LP + t0) * QKD; kvoff = ((size_t)(b * NH + wid) * (LP / 64) + t0 / 64) * KVT_BYTES; }
    else { const int mm = m0 - MP; b = mm / LS; t0 = mm % LS; L = LS; qoff = QS_OFF + ((size_t)(b * NH + wid) * LS + t0) * QKD; kvoff = KVS_OFF + ((size_t)(b * NH + wid) * (LS / 64) + t0 / 64) * KVT_BYTES; }
    (void)L;
    const float2* rope = (const float2*)(F.ws + WS_ROPE);
#pragma unroll 1
    for (int tb = 0; tb < 2; ++tb) {
        const bf16* wq = (const bf16*)(F.ws + WS_WQB) + ((size_t)(wid * 3) * 16 * 64 + lane) * 8;
        const int tok = tb * 32 + r32;
        f32x16 acc[3];
#pragma unroll
        for (int a = 0; a < 3; ++a) acc[a] = (f32x16){};
#pragma unroll 2
        for (int ks = 0; ks < 16; ++ks) {
            const bf16x8 b0 = *(const bf16x8*)(LQ + ((2 * ks + hi) * 64 + tok) * 16);
#pragma unroll
            for (int ft = 0; ft < 3; ++ft) { const bf16x8 a = *(const bf16x8*)(wq + (size_t)((ft * 16 + ks) * 64) * 8);
                acc[ft] = __builtin_amdgcn_mfma_f32_32x32x16_bf16(a, b0, acc[ft], 0, 0, 0); }
        }
        const float* qnw = F.in[19];
        bf16* qr = (bf16*)(F.ws + WS_A) + qoff + (size_t)tok * QKD;
        const float s = RS[tok]; float ss = 0.f;
#pragma unroll
        for (int ft = 0; ft < 3; ++ft)
#pragma unroll
            for (int r = 0; r < 16; ++r) { const float v = acc[ft][r] * s; acc[ft][r] = v; ss += v * v; }
        ss += __shfl_xor(ss, 32);
        const float rq = 1.0f / sqrtf(ss * (1.0f / QKD) + EPS);
#pragma unroll
        for (int ft = 0; ft < 3; ++ft)
#pragma unroll
            for (int r = 0; r < 16; ++r) acc[ft][r] *= rq * qnw[32 * ft + crow(r, hi)];
#pragma unroll
        for (int r = 0; r < 8; ++r) { const float2 cs = rope[(size_t)(t0 + tok) * 16 + crow(r, hi)]; const float a = acc[2][r], bq = acc[2][r + 8];
            acc[2][r] = a * cs.x - bq * cs.y; acc[2][r + 8] = a * cs.y + bq * cs.x; }
#pragma unroll
        for (int ft = 0; ft < 3; ++ft)
#pragma unroll
            for (int g = 0; g < 4; ++g) { u32x2 w; w.x = pk2(acc[ft][4 * g] * QSCALE, acc[ft][4 * g + 1] * QSCALE); w.y = pk2(acc[ft][4 * g + 2] * QSCALE, acc[ft][4 * g + 3] * QSCALE);
                *(u32x2*)(qr + 32 * ft + 8 * g + 4 * hi) = w; }
    }
#pragma unroll 1
    for (int it = 0; it < 4; ++it) {
        const int half = it >> 1, tb = it & 1, tok = tb * 32 + r32;
        const bf16* wkv = (const bf16*)(F.ws + WS_WKVB) + ((size_t)((wid * 4 + half * 2) * 8) * 64 + lane) * 8;
        const float* knw = F.in[20];
        unsigned char* KT = F.ws + WS_C + kvoff;
        f32x16 acc[2];
        acc[0] = (f32x16){}; acc[1] = (f32x16){};
#pragma unroll 2
        for (int ks = 0; ks < 8; ++ks) {
            const bf16x8 b0 = *(const bf16x8*)(LKV + ((2 * ks + hi) * 64 + tok) * 16);
#pragma unroll
            for (int ft = 0; ft < 2; ++ft) { const bf16x8 a = *(const bf16x8*)(wkv + (size_t)((ft * 8 + ks) * 64) * 8);
                acc[ft] = __builtin_amdgcn_mfma_f32_32x32x16_bf16(a, b0, acc[ft], 0, 0, 0); }
        }
        const float s = RS[64 + tok];
        if (half == 0) {
            float ss = 0.f;
#pragma unroll
            for (int ft = 0; ft < 2; ++ft)
#pragma unroll
                for (int r = 0; r < 16; ++r) { const float v = acc[ft][r] * s; acc[ft][r] = v; ss += v * v; }
            const u32x4 ka = *(const u32x4*)(LKR + tok * 64 + hi * 16), kb = *(const u32x4*)(LKR + tok * 64 + 32 + hi * 16);
            float fa[8], fb[8]; { const unsigned wa[4] = {ka.x, ka.y, ka.z, ka.w}, wb[4] = {kb.x, kb.y, kb.z, kb.w};
#pragma unroll
                for (int e = 0; e < 4; ++e) { fa[2 * e] = __uint_as_float(wa[e] << 16); fa[2 * e + 1] = __uint_as_float(wa[e] & 0xffff0000u); fb[2 * e] = __uint_as_float(wb[e] << 16); fb[2 * e + 1] = __uint_as_float(wb[e] & 0xffff0000u); } }
#pragma unroll
            for (int j = 0; j < 8; ++j) ss += fa[j] * fa[j] + fb[j] * fb[j];
            ss += __shfl_xor(ss, 32);
            const float rk = 1.0f / sqrtf(ss * (1.0f / QKD) + EPS);
#pragma unroll
            for (int ft = 0; ft < 2; ++ft)
#pragma unroll
                for (int g = 0; g < 4; ++g) { float v[4];
#pragma unroll
                    for (int e = 0; e < 4; ++e) v[e] = acc[ft][4 * g + e] * rk * knw[32 * ft + 8 * g + 4 * hi + e];
                    u32x2 w; w.x = pk2(v[0], v[1]); w.y = pk2(v[2], v[3]);
                    *(u32x2*)(KT + (((4 * ft + g) * 64 + tok) * 8 + 4 * hi) * 2) = w; }
            { float oa[8], ob[8];
#pragma unroll
              for (int j = 0; j < 8; ++j) { const int i = 8 * hi + j; const float2 cs = rope[(size_t)(t0 + tok) * 16 + i]; const float a = fa[j] * rk * knw[64 + i], bq = fb[j] * rk * knw[80 + i];
                  oa[j] = a * cs.x - bq * cs.y; ob[j] = a * cs.y + bq * cs.x; }
              u32x4 wa, wb; wa.x = pk2(oa[0], oa[1]); wa.y = pk2(oa[2], oa[3]); wa.z = pk2(oa[4], oa[5]); wa.w = pk2(oa[6], oa[7]); wb.x = pk2(ob[0], ob[1]); wb.y = pk2(ob[2], ob[3]); wb.z = pk2(ob[4], ob[5]); wb.w = pk2(ob[6], ob[7]);
              *(u32x4*)(KT + ((8 + hi) * 64 + tok) * 16) = wa; *(u32x4*)(KT + ((10 + hi) * 64 + tok) * 16) = wb; }
        } else {
#pragma unroll
            for (int ft = 0; ft < 2; ++ft)
#pragma unroll
                for (int g = 0; g < 4; ++g) { u32x2 w; w.x = pk2(acc[ft][4 * g] * s, acc[ft][4 * g + 1] * s); w.y = pk2(acc[ft][4 * g + 2] * s, acc[ft][4 * g + 3] * s);
                    *(u32x2*)(KT + KT_BYTES + ((ft * 64 + tok) * 32 + 8 * g + 4 * hi) * 2) = w; }
        }
    }
    __syncthreads();
}
__device__ __forceinline__ void p2_mla_wg(Frame& F, int u) {
    const int tid = (int)threadIdx.x, lane = tid & 63, wid = F.wave, r32 = lane & 31, hi = lane >> 5;
    unsigned char* lds = F.lds;
    const bf16* proj = (const bf16*)(F.ws + WS_B);
    const bool comp = wid < 6;
    const int mb = u * 192 + (comp ? wid : 0) * 32;
    int b, t0, L; size_t qbase, kvbase;
    if (mb < MP) { b = mb / LP; t0 = mb % LP; L = LP; qbase = (size_t)(b * NH) * LP * QKD; kvbase = (size_t)(b * NH) * (LP / 64) * KVT_BYTES; }
    else { const int mm = mb - MP; b = mm / LS; t0 = mm % LS; L = LS; qbase = QS_OFF + (size_t)(b * NH) * LS * QKD; kvbase = KVS_OFF + (size_t)(b * NH) * (LS / 64) * KVT_BYTES; }
    const int tk = (t0 & 63) + r32;
    const float2* rope = (const float2*)(F.ws + WS_ROPE);
    int hi8 = 8 * hi; asm volatile("" : "+v"(hi8));
    const bf16* row = proj + (size_t)(mb + r32) * NIN + hi8;
    const float* qnw = F.in[19]; const float* knw = F.in[20];
    const unsigned lds0 = (unsigned)(uintptr_t)lds;
#define P2_GLDS(gsrc_, ldst_) do { unsigned keep_; asm volatile("s_mov_b32 %0, m0\n\ts_mov_b32 m0, %2\n\ts_nop 0\n\tglobal_load_lds_dwordx4 %1, off\n\ts_mov_b32 m0, %0" : "=&s"(keep_) : "v"(gsrc_), "s"(ldst_) : "memory"); } while (0)
#define P2_DMA(ci_) do { const int c_ = (ci_); const int np_ = c_ < 8 ? 6 : 4; unsigned lo2_ = (unsigned)lane * 16u; asm volatile("" : "+v"(lo2_)); \
        const unsigned char* g_ = chunk_src(c_) + wid * 1024 + lo2_; const unsigned l_ = (unsigned)__builtin_amdgcn_readfirstlane((int)(lds0 + (c_ & 1) * 49152 + wid * 1024)); \
        _Pragma("unroll") for (int j_ = 0; j_ < 6; ++j_) if (j_ < np_) P2_GLDS(g_ + j_ * 8192, l_ + (unsigned)(j_ * 8192)); } while (0)
    auto chunk_src = [&](int i) -> const unsigned char* { return i < 8 ? F.ws + WS_WQB + (size_t)i * 49152 : F.ws + WS_WKVB + (size_t)(i - 8) * 32768; };
    float* nwl = (float*)(lds + 98304);
    if (tid < 96) nwl[tid] = qnw[tid]; else if (tid < 192) nwl[tid] = knw[tid - 96];
    P2_DMA(0);
    asm volatile("s_waitcnt vmcnt(0)" ::: "memory");
    __syncthreads();
    {
        bf16x8 bq[16]; float rsq; float2 ropq[8];
#pragma unroll
        for (int r = 0; r < 8; ++r) ropq[r] = rope[(size_t)(t0 + r32) * 16 + crow(r, hi)];
        { float sq = 0.f;
#pragma unroll
          for (int ks = 0; ks < 16; ++ks) { bq[ks] = *(const bf16x8*)(row + COL_Q + 16 * ks);
#pragma unroll
              for (int j = 0; j < 8; ++j) { const float v = bf2f((unsigned short)bq[ks][j]); sq += v * v; } }
          sq += __shfl_xor(sq, 32); rsq = 1.0f / sqrtf(sq * (1.0f / QLORA) + EPS); }
#pragma unroll 1
        for (int i = 0; i < 8; ++i) {
            const unsigned char* wl = lds + (i & 1) * 49152;
            P2_DMA(i + 1);
            if (comp) {
                unsigned lo_ = (unsigned)lane * 16u; asm volatile("" : "+v"(lo_)); const unsigned char* wll = wl + lo_;
                const int h = i; f32x16 acc[3];
#pragma unroll
                for (int a = 0; a < 3; ++a) acc[a] = (f32x16){};
#pragma unroll
                for (int ks = 0; ks < 16; ++ks) {
#pragma unroll
                    for (int ft = 0; ft < 3; ++ft) { const bf16x8 a = *(const bf16x8*)(wll + ((ft * 16 + ks) * 64) * 16); acc[ft] = __builtin_amdgcn_mfma_f32_32x32x16_bf16(a, bq[ks], acc[ft], 0, 0, 0); }
                    if ((ks & 3) == 3) __builtin_amdgcn_sched_barrier(0);
                }
                float ss = 0.f;
#pragma unroll
                for (int ft = 0; ft < 3; ++ft)
#pragma unroll
                    for (int r = 0; r < 16; ++r) { const float v = acc[ft][r] * rsq; acc[ft][r] = v; ss += v * v; }
                ss += __shfl_xor(ss, 32);
                const float rq = 1.0f / sqrtf(ss * (1.0f / QKD) + EPS);
#pragma unroll
                for (int ft = 0; ft < 3; ++ft)
#pragma unroll
                    for (int g = 0; g < 4; ++g) { const f32x4 w4 = *(const f32x4*)(nwl + 32 * ft + 8 * g + 4 * hi);
#pragma unroll
                        for (int e2 = 0; e2 < 4; ++e2) acc[ft][4 * g + e2] *= rq * w4[e2]; }
#pragma unroll
                for (int r = 0; r < 8; ++r) { const float2 cs = ropq[r]; const float a = acc[2][r], bqv = acc[2][r + 8];
                    acc[2][r] = a * cs.x - bqv * cs.y; acc[2][r + 8] = a * cs.y + bqv * cs.x; }
                bf16* qr = (bf16*)(F.ws + WS_A) + qbase + ((size_t)h * L + t0 + r32) * QKD;
#pragma unroll
                for (int ft = 0; ft < 3; ++ft)
#pragma unroll
                    for (int g = 0; g < 4; ++g) { u32x2 w; w.x = pk2(acc[ft][4 * g] * QSCALE, acc[ft][4 * g + 1] * QSCALE); w.y = pk2(acc[ft][4 * g + 2] * QSCALE, acc[ft][4 * g + 3] * QSCALE);
                        *(u32x2*)(qr + 32 * ft + 8 * g + 4 * hi) = w; }
            }
            asm volatile("s_waitcnt vmcnt(0)" ::: "memory");
            __syncthreads();
        }
    }
    {
        bf16x8 bkv[8]; float rskv; float fa[8], fb[8]; float ssr = 0.f; float2 ropk[8];
#pragma unroll
        for (int j = 0; j < 8; ++j) ropk[j] = rope[(size_t)(t0 + r32) * 16 + 8 * hi + j];
        { float skv = 0.f;
#pragma unroll
          for (int ks = 0; ks < 8; ++ks) { bkv[ks] = *(const bf16x8*)(row + COL_KV + 16 * ks);
#pragma unroll
              for (int j = 0; j < 8; ++j) { const float v = bf2f((unsigned short)bkv[ks][j]); skv += v * v; } }
          skv += __shfl_xor(skv, 32); rskv = 1.0f / sqrtf(skv * (1.0f / KVLORA) + EPS);
          const u32x4 kra = *(const u32x4*)(row + COL_KR), krb = *(const u32x4*)(row + COL_KR + 16);
          const unsigned wa[4] = {kra.x, kra.y, kra.z, kra.w}, wb[4] = {krb.x, krb.y, krb.z, krb.w};
#pragma unroll
          for (int e = 0; e < 4; ++e) { fa[2 * e] = __uint_as_float(wa[e] << 16); fa[2 * e + 1] = __uint_as_float(wa[e] & 0xffff0000u); fb[2 * e] = __uint_as_float(wb[e] << 16); fb[2 * e + 1] = __uint_as_float(wb[e] & 0xffff0000u); }
#pragma unroll
          for (int j = 0; j < 8; ++j) ssr += fa[j] * fa[j] + fb[j] * fb[j]; }
#pragma unroll 1
        for (int i = 8; i < 16; ++i) {
            const unsigned char* wl = lds + (i & 1) * 49152;
            if (i + 1 < 16) P2_DMA(i + 1);
            if (comp) {
                unsigned lo_ = (unsigned)lane * 16u; asm volatile("" : "+v"(lo_)); const unsigned char* wll = wl + lo_;
                const int h = i - 8; f32x16 acc[4]; const float* knl = nwl + 96;
#pragma unroll
                for (int a = 0; a < 4; ++a) acc[a] = (f32x16){};
#pragma unroll
                for (int ks = 0; ks < 8; ++ks) {
#pragma unroll
                    for (int ft = 0; ft < 4; ++ft) { const bf16x8 a = *(const bf16x8*)(wll + ((ft * 8 + ks) * 64) * 16); acc[ft] = __builtin_amdgcn_mfma_f32_32x32x16_bf16(a, bkv[ks], acc[ft], 0, 0, 0); }
                    if ((ks & 1) == 1) __builtin_amdgcn_sched_barrier(0);
                }
                unsigned char* KT = F.ws + WS_C + kvbase + ((size_t)h * (L / 64) + (t0 >> 6)) * KVT_BYTES;
                float ss = ssr;
#pragma unroll
                for (int ft = 0; ft < 2; ++ft)
#pragma unroll
                    for (int r = 0; r < 16; ++r) { const float v = acc[ft][r] * rskv; acc[ft][r] = v; ss += v * v; }
                ss += __shfl_xor(ss, 32);
                const float rk = 1.0f / sqrtf(ss * (1.0f / QKD) + EPS);
#pragma unroll
                for (int ft = 0; ft < 2; ++ft)
#pragma unroll
                    for (int g = 0; g < 4; ++g) { float v[4]; const f32x4 w4 = *(const f32x4*)(knl + 32 * ft + 8 * g + 4 * hi);
#pragma unroll
                        for (int e = 0; e < 4; ++e) v[e] = acc[ft][4 * g + e] * rk * w4[e];
                        u32x2 w; w.x = pk2(v[0], v[1]); w.y = pk2(v[2], v[3]);
                        *(u32x2*)(KT + (((4 * ft + g) * 64 + tk) * 8 + 4 * hi) * 2) = w; }
                { float oa[8], ob[8];
#pragma unroll
                  for (int j = 0; j < 8; ++j) { const int ii = 8 * hi + j; const float2 cs = ropk[j]; const float a = fa[j] * rk * knl[64 + ii], bqv = fb[j] * rk * knl[80 + ii];
                      oa[j] = a * cs.x - bqv * cs.y; ob[j] = a * cs.y + bqv * cs.x; }
                  u32x4 wa2, wb2; wa2.x = pk2(oa[0], oa[1]); wa2.y = pk2(oa[2], oa[3]); wa2.z = pk2(oa[4], oa[5]); wa2.w = pk2(oa[6], oa[7]); wb2.x = pk2(ob[0], ob[1]); wb2.y = pk2(ob[2], ob[3]); wb2.z = pk2(ob[4], ob[5]); wb2.w = pk2(ob[6], ob[7]);
                  *(u32x4*)(KT + ((8 + hi) * 64 + tk) * 16) = wa2; *(u32x4*)(KT + ((10 + hi) * 64 + tk) * 16) = wb2; }
#pragma unroll
                for (int ft = 2; ft < 4; ++ft)
#pragma unroll
                    for (int g = 0; g < 4; ++g) { u32x2 w; w.x = pk2(acc[ft][4 * g] * rskv, acc[ft][4 * g + 1] * rskv); w.y = pk2(acc[ft][4 * g + 2] * rskv, acc[ft][4 * g + 3] * rskv);
                        *(u32x2*)(KT + KT_BYTES + (((ft - 2) * 64 + tk) * 32 + 8 * g + 4 * hi) * 2) = w; }
            }
            asm volatile("s_waitcnt vmcnt(0)" ::: "memory");
            __syncthreads();
        }
    }
}
#undef P2_GLDS
#undef P2_DMA
__device__ __forceinline__ void p2_hyena_front(Frame& F, int unit) {
    const int c = ((int)threadIdx.x); const int m0 = unit * 64;
    int b, t0, L; bf16* zt; bf16* x0t;
    bf16* zbase = (bf16*)F.out; bf16* xbase = (bf16*)(F.out + (size_t)MT * HYW);
    if (m0 < MP) { b = m0 / LP; t0 = m0 % LP; L = LP; zt = zbase + ((size_t)(b * HYW + c) * LP + t0); x0t = xbase + ((size_t)(b * HYW + c) * LP + t0); }
    else { const int mm = m0 - MP; b = mm / LS; t0 = mm % LS; L = LS; zt = zbase + (size_t)MP * HYW + ((size_t)(b * HYW + c) * LS + t0); x0t = xbase + (size_t)MP * HYW + ((size_t)(b * HYW + c) * LS + t0); }
    const bf16* proj = (const bf16*)(F.ws + WS_B) + (size_t)(m0 - t0) * NIN;
    const float* cw = F.in[6]; const float* cb = F.in[7];
    float w0[3], w1[3], w2[3], bb[3];
#pragma unroll
    for (int s = 0; s < 3; ++s) { w0[s] = cw[0 * 1536 + s * 512 + c]; w1[s] = cw[1 * 1536 + s * 512 + c]; w2[s] = cw[2 * 1536 + s * 512 + c]; bb[s] = cb[s * 512 + c]; }
    float pv[3], cv[3], nv[3];
    auto ld = [&](int t, float (&d)[3]) { const bool ok = (t >= 0) && (t < L); const int tc = t < 0 ? 0 : (t >= L ? L - 1 : t); const bf16* r = proj + (size_t)tc * NIN + c;
        const float a0 = bf2f(r[0]), a1 = bf2f(r[512]), a2 = bf2f(r[1024]); d[0] = ok ? a0 : 0.f; d[1] = ok ? a1 : 0.f; d[2] = ok ? a2 : 0.f; };
    ld(t0 - 1, pv); ld(t0, cv);
#pragma unroll 1
    for (int sb = 0; sb < 2; ++sb) {
    float zo[32], xo[32];
#pragma unroll
    for (int i = 0; i < 32; ++i) { ld(t0 + 32 * sb + i + 1, nv);
        float u[3];
#pragma unroll
        for (int s = 0; s < 3; ++s) u[s] = bb[s] + pv[s] * w0[s] + cv[s] * w1[s] + nv[s] * w2[s];
        xo[i] = u[0]; zo[i] = u[2] * u[1];
#pragma unroll
        for (int s = 0; s < 3; ++s) { pv[s] = cv[s]; cv[s] = nv[s]; } }
#pragma unroll
    for (int i = 0; i < 4; ++i) { u32x4 w; w.x = pk2(zo[8 * i], zo[8 * i + 1]); w.y = pk2(zo[8 * i + 2], zo[8 * i + 3]); w.z = pk2(zo[8 * i + 4], zo[8 * i + 5]); w.w = pk2(zo[8 * i + 6], zo[8 * i + 7]); ((u32x4*)zt)[i] = w; }
#pragma unroll
    for (int i = 0; i < 4; ++i) { u32x4 w; w.x = pk2(xo[8 * i], xo[8 * i + 1]); w.y = pk2(xo[8 * i + 2], xo[8 * i + 3]); w.z = pk2(xo[8 * i + 4], xo[8 * i + 5]); w.w = pk2(xo[8 * i + 6], xo[8 * i + 7]); ((u32x4*)x0t)[i] = w; }
    zt += 32; x0t += 32;
    }
}

__device__ __forceinline__ void p2_filter_item(Frame& F, int item) {
    const int tid = (int)threadIdx.x;
    const bool prompt = item < 512; const int it = prompt ? item : item - 512;
    const int L = prompt ? LP : LS; const int cg = prompt ? (it >> 2) : it, pc = prompt ? (it & 3) : 0;
    const int c0 = cg * 8, j4 = pc * 2048 + tid * 4;
    const float* h2 = (const float*)(F.ws + (prompt ? WS_H2P : WS_H2S)); const float* w3 = F.in[13] + c0;
    float* kern = (float*)(F.ws + (prompt ? WS_KERNP : WS_KERNS));
    f32x4 acc[8];
#pragma unroll
    for (int c = 0; c < 8; ++c) acc[c] = (f32x4){0.f, 0.f, 0.f, 0.f};
#pragma unroll 8
    for (int k = 0; k < 64; ++k) { const f32x4 hv = *(const f32x4*)(h2 + (size_t)k * L + j4); const f32x4 wa = *(const f32x4*)(w3 + k * 1024), wb = *(const f32x4*)(w3 + k * 1024 + 4);
        acc[0] += hv * wa.x; acc[1] += hv * wa.y; acc[2] += hv * wa.z; acc[3] += hv * wa.w; acc[4] += hv * wb.x; acc[5] += hv * wb.y; acc[6] += hv * wb.z; acc[7] += hv * wb.w; }
    const float min_decay = -15.350567286626973f, max_decay = -3.0701134573253945f; const float rl = 1.0f / (float)(L - 1);
#pragma unroll
    for (int c = 0; c < 8; ++c) { const int ch = (c0 + c) & 511; const float delta = fabsf(min_decay + (float)ch * ((max_decay - min_decay) / 511.0f)); f32x4 o;
#pragma unroll
        for (int e = 0; e < 4; ++e) o[e] = acc[c][e] * expf(-((float)(j4 + e) * rl) * delta);
        *(f32x4*)(kern + (size_t)(c0 + c) * L + j4) = o; }
}

__device__ __forceinline__ s16x4 vtr(const unsigned char* p) { typedef short v4i16_t __attribute__((ext_vector_type(4)));
    return __builtin_bit_cast(s16x4, __builtin_amdgcn_ds_read_tr16_b64_v4i16((LAS v4i16_t*)p)); }
__device__ __forceinline__ unsigned cvtpk(float lo, float hi) { typedef float f2 __attribute__((ext_vector_type(2))); typedef __bf16 b2 __attribute__((ext_vector_type(2))); f2 v = {lo, hi}; b2 r = __builtin_convertvector(v, b2); return __builtin_bit_cast(unsigned, r); }
__device__ __forceinline__ float max3f(float a, float b, float c) { float r; asm("v_max3_f32 %0, %1, %2, %3" : "=v"(r) : "v"(a), "v"(b), "v"(c)); return r; }
typedef float f32x2a __attribute__((ext_vector_type(2)));
#ifndef ATT_SCHED
#define ATT_SCHED 1
#endif
#ifndef ATT_THR
#define ATT_THR 8.0f
#endif
#ifndef ATT_TRACK_LIMIT
#define ATT_TRACK_LIMIT 4.0f
#endif
template <bool LAST> __device__ __forceinline__ void attn_step(f32x16& p0, f32x16& p1, f32x16& q0, f32x16& q1, f32x16& o0, f32x16& o1, float& mrun, float& lsum, f32x16& negm, const bool track, const bf16x8 (&qr)[6],
        const unsigned char* lds, int t, int NT, const unsigned char* KV, int tid, int r32, int hi, int voff) {
    const int cur = t % 3, nxt = (t + 1) % 3, nn = (t + 2) % 3;
    u32x4 s0, s1, s2 = (u32x4){0u, 0u, 0u, 0u};
    if (!LAST) { const int tl = (t + 2 < NT) ? t + 2 : NT - 1; const u32x4* src = (const u32x4*)(KV + (size_t)tl * KVT_BYTES); s0 = src[tid]; s1 = src[tid + 512]; if (tid < 256) s2 = src[tid + 1024]; }
    const unsigned char* kb = lds + nxt * KVT_BYTES;
    const unsigned char* vb = lds + cur * KVT_BYTES + KT_BYTES + voff;
    bf16x8 kf[12];
    if (!LAST) {
#pragma unroll
        for (int d = 0; d < 6; ++d) { kf[2 * d] = *(const bf16x8*)(kb + ((2 * d + hi) * 64 + r32) * 16); kf[2 * d + 1] = *(const bf16x8*)(kb + ((2 * d + hi) * 64 + 32 + r32) * 16); }
    }
    s16x4 va[8], vc[8];
#pragma unroll
    for (int s = 0; s < 4; ++s) { va[2 * s] = vtr(vb + s * 1024); va[2 * s + 1] = vtr(vb + s * 1024 + 512); vc[2 * s] = vtr(vb + 4096 + s * 1024); vc[2 * s + 1] = vtr(vb + 4096 + s * 1024 + 512); }
    if (!LAST) {
        q0 = __builtin_amdgcn_mfma_f32_32x32x16_bf16(kf[0], qr[0], negm, 0, 0, 0); q1 = __builtin_amdgcn_mfma_f32_32x32x16_bf16(kf[1], qr[0], negm, 0, 0, 0);
#pragma unroll
        for (int d = 1; d < 6; ++d) { q0 = __builtin_amdgcn_mfma_f32_32x32x16_bf16(kf[2 * d], qr[d], q0, 0, 0, 0); q1 = __builtin_amdgcn_mfma_f32_32x32x16_bf16(kf[2 * d + 1], qr[d], q1, 0, 0, 0); }
    }
    if (track) {
        float mx = max3f(p0[0], p0[1], p1[0]);
#pragma unroll
        for (int r = 2; r < 16; r += 2) mx = max3f(mx, p0[r], p0[r + 1]);
#pragma unroll
        for (int r = 1; r < 15; r += 2) mx = max3f(mx, p1[r], p1[r + 1]);
        mx = fmaxf(mx, p1[15]);
        { auto rr = __builtin_amdgcn_permlane32_swap(__float_as_uint(mx), __float_as_uint(mx), false, false); mx = fmaxf(__uint_as_float(rr[0]), __uint_as_float(rr[1])); }
        if (__any(mx > ATT_THR)) {
            const float dl = fmaxf(mx, 0.f); mrun += dl; const float alpha = __builtin_amdgcn_exp2f(-dl); lsum *= alpha;
#pragma unroll
            for (int r = 0; r < 16; ++r) { p0[r] -= dl; p1[r] -= dl; o0[r] *= alpha; o1[r] *= alpha; negm[r] = -mrun; }
            if (!LAST) {
#pragma unroll
                for (int r = 0; r < 16; ++r) { q0[r] -= dl; q1[r] -= dl; }
            }
        }
    }
    float psa = 0.f, psb = 0.f;
#pragma unroll
    for (int r = 0; r < 16; ++r) { p0[r] = __builtin_amdgcn_exp2f(p0[r]); p1[r] = __builtin_amdgcn_exp2f(p1[r]); psa += p0[r]; psb += p1[r]; }
    lsum += (psa + psb);
    u32x4 pw[4];
#pragma unroll
    for (int s = 0; s < 4; ++s) { const int bse = 8 * (s & 1);
        if (s < 2) pw[s] = (u32x4){cvtpk(p0[bse], p0[bse + 1]), cvtpk(p0[bse + 2], p0[bse + 3]), cvtpk(p0[bse + 4], p0[bse + 5]), cvtpk(p0[bse + 6], p0[bse + 7])};
        else pw[s] = (u32x4){cvtpk(p1[bse], p1[bse + 1]), cvtpk(p1[bse + 2], p1[bse + 3]), cvtpk(p1[bse + 4], p1[bse + 5]), cvtpk(p1[bse + 6], p1[bse + 7])}; }
#if ATT_SCHED
    if (!LAST) {
#pragma unroll
        for (int i = 0; i < 12; ++i) { __builtin_amdgcn_sched_group_barrier(0x008, 1, 0); __builtin_amdgcn_sched_group_barrier(0x002, 12, 0); }
    }
#endif
#pragma unroll
    for (int s = 0; s < 4; ++s) {
        const s16x4 a0 = va[2 * s], a1 = va[2 * s + 1], c0 = vc[2 * s], c1 = vc[2 * s + 1];
        const bf16x8 v0 = (bf16x8){a0[0], a0[1], a0[2], a0[3], a1[0], a1[1], a1[2], a1[3]}, v1 = (bf16x8){c0[0], c0[1], c0[2], c0[3], c1[0], c1[1], c1[2], c1[3]};
        const bf16x8 pf = __builtin_bit_cast(bf16x8, pw[s]);
        o0 = __builtin_amdgcn_mfma_f32_32x32x16_bf16(v0, pf, o0, 0, 0, 0); o1 = __builtin_amdgcn_mfma_f32_32x32x16_bf16(v1, pf, o1, 0, 0, 0);
    }
    if (!LAST) { u32x4* dst = (u32x4*)(lds + nn * KVT_BYTES); dst[tid] = s0; dst[tid + 512] = s1; if (tid < 256) dst[tid + 1024] = s2; }
    __syncthreads();
}
__device__ __forceinline__ void attn_unit(Frame& F, bool prompt, int bh, int qb) {
    const int tid = ((int)threadIdx.x), lane = ((int)threadIdx.x & 63), wid = F.wave, r32 = lane & 31, hi = lane >> 5;
    const int L = prompt ? LP : LS, NT = L / 64;
    const bf16* Qg = (const bf16*)(F.ws + WS_A) + (prompt ? 0 : QS_OFF) + ((size_t)bh * L + qb * 256 + wid * 32 + r32) * QKD + hi * 8;
    const unsigned char* KV = F.ws + WS_C + (prompt ? 0 : KVS_OFF) + (size_t)bh * NT * KVT_BYTES;
    unsigned char* lds = F.lds;
    bf16x8 qr[6];
#pragma unroll
    for (int d = 0; d < 6; ++d) qr[d] = *(const bf16x8*)(Qg + d * 16);
    f32x16 o0 = (f32x16){}, o1 = (f32x16){}; float mrun = 0.f, lsum = 0.f;
    { const u32x4* src = (const u32x4*)KV; u32x4* dst = (u32x4*)lds;
#pragma unroll
      for (int j = 0; j < 2; ++j) { const u32x4 a = src[j * 1280 + tid], b = src[j * 1280 + tid + 512]; u32x4 c = (u32x4){0u, 0u, 0u, 0u}; if (tid < 256) c = src[j * 1280 + tid + 1024];
          dst[j * 1280 + tid] = a; dst[j * 1280 + tid + 512] = b; if (tid < 256) dst[j * 1280 + tid + 1024] = c; } }
    __syncthreads();
    const int voff = (4 * hi + ((lane & 15) >> 2)) * 64 + ((lane >> 4) & 1) * 32 + (lane & 3) * 8;
    f32x16 pa0 = (f32x16){}, pa1 = (f32x16){}, pb0, pb1;
#pragma unroll
    for (int d = 0; d < 6; ++d) {
        const bf16x8 k0 = *(const bf16x8*)(lds + ((2 * d + hi) * 64 + r32) * 16), k1 = *(const bf16x8*)(lds + ((2 * d + hi) * 64 + 32 + r32) * 16);
        pa0 = __builtin_amdgcn_mfma_f32_32x32x16_bf16(k0, qr[d], pa0, 0, 0, 0); pa1 = __builtin_amdgcn_mfma_f32_32x32x16_bf16(k1, qr[d], pa1, 0, 0, 0);
    }
    f32x16 negm;
    { float mx = fmaxf(pa0[0], pa1[0]);
#pragma unroll
      for (int r = 1; r < 16; ++r) mx = fmaxf(mx, fmaxf(pa0[r], pa1[r]));
      mx = fmaxf(mx, __shfl_xor(mx, 32)); mrun = mx;
#pragma unroll
      for (int r = 0; r < 16; ++r) { pa0[r] -= mx; pa1[r] -= mx; negm[r] = -mx; } }
    bool track;
    { const float* qnw = F.in[19]; const float* knw = F.in[20]; float gq = 0.f, gk = 0.f;
      for (int i = 0; i < QKD; ++i) { gq = fmaxf(gq, fabsf(qnw[i])); gk = fmaxf(gk, fabsf(knw[i])); }
      track = !(gq * gk < ATT_TRACK_LIMIT); }
    int t = 0;
    for (; t + 2 < NT; t += 2) {
        attn_step<false>(pa0, pa1, pb0, pb1, o0, o1, mrun, lsum, negm, track, qr, lds, t, NT, KV, tid, r32, hi, voff);
        attn_step<false>(pb0, pb1, pa0, pa1, o0, o1, mrun, lsum, negm, track, qr, lds, t + 1, NT, KV, tid, r32, hi, voff);
    }
    attn_step<false>(pa0, pa1, pb0, pb1, o0, o1, mrun, lsum, negm, track, qr, lds, t, NT, KV, tid, r32, hi, voff);
    attn_step<true>(pb0, pb1, pa0, pa1, o0, o1, mrun, lsum, negm, track, qr, lds, t + 1, NT, KV, tid, r32, hi, voff);
    lsum += __shfl_xor(lsum, 32);
    const float il = 1.0f / lsum;
    const int b = bh >> 3, h = bh & 7;
    const size_t mrow = (prompt ? 0 : (size_t)MP) + (size_t)b * L + qb * 256 + wid * 32 + r32;
    float* yo = (float*)(F.ws + WS_YMLA) + mrow * 512 + h * 64 + 4 * hi;
#pragma unroll
    for (int g = 0; g < 4; ++g) { *(f32x4*)(yo + 8 * g) = (f32x4){o0[4 * g] * il, o0[4 * g + 1] * il, o0[4 * g + 2] * il, o0[4 * g + 3] * il};
        *(f32x4*)(yo + 32 + 8 * g) = (f32x4){o1[4 * g] * il, o1[4 * g + 1] * il, o1[4 * g + 2] * il, o1[4 * g + 3] * il}; }
}

__device__ __forceinline__ float2 cmul(float2 a, float2 b) { return make_float2(ffms_s(a.x, b.x, fmul_s(a.y, b.y)), ffma_s(a.x, b.y, fmul_s(a.y, b.x))); }
__device__ __forceinline__ float2 cmulc(float2 a, float2 b) { return make_float2(ffma_s(a.x, b.x, fmul_s(a.y, b.y)), ffms_s(a.y, b.x, fmul_s(a.x, b.y))); }
__device__ __forceinline__ float2 cadd(float2 a, float2 b) { return make_float2(fadd_s(a.x, b.x), fadd_s(a.y, b.y)); }
__device__ __forceinline__ float2 csub(float2 a, float2 b) { return make_float2(fsub_s(a.x, b.x), fsub_s(a.y, b.y)); }
template <bool INV> __device__ __forceinline__ void bfly4(float2& x0, float2& x1, float2& x2, float2& x3, float rev, float one, float mone) {
    const float2 w1 = make_float2(__builtin_amdgcn_cosf(rev) * one, __builtin_amdgcn_sinf(rev) * mone); const float2 w2 = cmul(w1, w1), w3 = cmul(w2, w1);
    if (!INV) {
        const float2 a = cadd(x0, x2), bq = csub(x0, x2), c = cadd(x1, x3), d = csub(x1, x3);
        const float2 y1 = make_float2(fadd_s(bq.x, d.y), fsub_s(bq.y, d.x)), y3 = make_float2(fsub_s(bq.x, d.y), fadd_s(bq.y, d.x));
        x0 = cadd(a, c); x2 = cmul(csub(a, c), w2); x1 = cmul(y1, w1); x3 = cmul(y3, w3);
    } else {
        x1 = cmulc(x1, w1); x2 = cmulc(x2, w2); x3 = cmulc(x3, w3);
        const float2 a = cadd(x0, x2), bq = csub(x0, x2), c = cadd(x1, x3), d = csub(x1, x3);
        x0 = cadd(a, c); x2 = csub(a, c); x1 = make_float2(fsub_s(bq.x, d.y), fadd_s(bq.y, d.x)); x3 = make_float2(fadd_s(bq.x, d.y), fsub_s(bq.y, d.x));
    }
}
#define PHI(i) ((i) + ((i) >> 4))
#define PADN(n) ((n) + ((n) >> 4))
template <bool INV> __device__ __forceinline__ void fft_lds(float2* buf0, int N, int logN, const float2* tw, int tid, int nbuf = 1) {
    (void)tw;
    float one = 1.0f, mone = -1.0f; asm volatile("" : "+v"(one), "+v"(mone));
    const int nst = logN >> 1, npair = nst >> 1, odd = nst & 1;
    const int npass = npair + odd;
    for (int ps = 0; ps < npass; ++ps) {
        const int pi = INV ? (npass - 1 - ps) : ps;
        if (pi < npair) {
            const int lsA = logN - 2 - 4 * pi, lsB = lsA - 2;
            const int s = 1 << lsA, sp = 1 << lsB;
            const float rA = 1.0f / (float)(4 * s), rB = 1.0f / (float)s;
#pragma unroll 2
            for (int gg = tid; gg < nbuf * (N >> 4); gg += NTHR) {
                const int g = gg & ((N >> 4) - 1); float2* buf = buf0 + (size_t)(gg >> (logN - 4)) * PADN(N);
                const int n0 = g & (sp - 1), base = ((g >> lsB) << (lsA + 2)) + n0;
                float2 x[4][4];
#pragma unroll
                for (int a = 0; a < 4; ++a)
#pragma unroll
                    for (int b = 0; b < 4; ++b) x[a][b] = buf[PHI(base + a * sp + b * s)];
                if (!INV) {
#pragma unroll
                    for (int a = 0; a < 4; ++a) bfly4<false>(x[a][0], x[a][1], x[a][2], x[a][3], (float)(n0 + a * sp) * rA, one, mone);
#pragma unroll
                    for (int q = 0; q < 4; ++q) bfly4<false>(x[0][q], x[1][q], x[2][q], x[3][q], (float)n0 * rB, one, mone);
                } else {
#pragma unroll
                    for (int q = 0; q < 4; ++q) bfly4<true>(x[0][q], x[1][q], x[2][q], x[3][q], (float)n0 * rB, one, mone);
#pragma unroll
                    for (int a = 0; a < 4; ++a) bfly4<true>(x[a][0], x[a][1], x[a][2], x[a][3], (float)(n0 + a * sp) * rA, one, mone);
                }
#pragma unroll
                for (int a = 0; a < 4; ++a)
#pragma unroll
                    for (int b = 0; b < 4; ++b) buf[PHI(base + a * sp + b * s)] = x[a][b];
            }
        } else {
#pragma unroll 4
            for (int g = tid; g < nbuf * (N >> 2); g += NTHR) {
                float2* buf = buf0;
                const int base = g << 2;
                const int pb = PHI(base);
                float2 x0 = buf[pb], x1 = buf[pb + 1], x2 = buf[pb + 2], x3 = buf[pb + 3];
                bfly4<INV>(x0, x1, x2, x3, 0.0f, one, mone);
                buf[pb] = x0; buf[pb + 1] = x1; buf[pb + 2] = x2; buf[pb + 3] = x3;
            }
        }
        __syncthreads();
    }
}
template <bool prompt> __device__ __forceinline__ void fft_unit(Frame& F, int c) {
    const int tid = ((int)threadIdx.x); constexpr int L = prompt ? LP : LS, N = 2 * L, logN = prompt ? 14 : 12, nb = prompt ? BP : BS;
    float2* buf = (float2*)F.lds; float* w3l = (float*)(F.lds + LDSX_OFF);
    const float2* tw = (const float2*)(F.ws + WS_TW);
    float2* kspec = (float2*)(F.ws + WS_KSPEC) + (size_t)blockIdx.x * 16384;
    const float* h2 = (const float*)(F.ws + (prompt ? WS_H2P : WS_H2S));
    const bf16* zbase = (const bf16*)F.out + (prompt ? 0 : (size_t)MP * HYW); bf16* xbase = (bf16*)(F.out + (size_t)MT * HYW) + (prompt ? 0 : (size_t)MP * HYW);
    const float* w3 = F.in[13];
#ifndef FFT_REP
#define FFT_REP 1
#endif
#pragma unroll 1
    for (int rep = 0; rep < FFT_REP; ++rep) {
    const float bias = F.in[14][c];
    { const float* kf_ = (const float*)(F.ws + (prompt ? WS_KERNP : WS_KERNS)) + (size_t)c * L; const float* kb_ = kf_ + (size_t)512 * L;
#pragma unroll
      for (int i = 0; i < L / NTHR; ++i) { const int j = tid + i * NTHR; buf[PHI(j)] = make_float2(kf_[j] + (j == 0 ? bias : 0.f), 0.f); buf[PHI(N - 1 - j)] = make_float2(kb_[j], 0.f); } }
    __syncthreads();
    fft_lds<false>(buf, N, logN, tw, tid);
#pragma unroll 8
    for (int i = 0; i < N / NTHR; ++i) { const int p = tid + i * NTHR; kspec[p] = buf[PHI(p)]; }
    __syncthreads();
    const float invN = 1.0f / (float)N;
    constexpr int NBUF = prompt ? 1 : 4;
    for (int rd = 0; rd < (nb / 2) / NBUF; ++rd) {
#pragma unroll
        for (int k = 0; k < NBUF; ++k) { const int pr = rd * NBUF + k; float2* bk = buf + (size_t)k * PADN(N);
            const bf16* za = zbase + ((size_t)((2 * pr) * HYW + c) * L); const bf16* zb = zbase + ((size_t)((2 * pr + 1) * HYW + c) * L);
#pragma unroll
            for (int i = 0; i < L / NTHR; ++i) { const int t = tid + i * NTHR; bk[PHI(t)] = make_float2(bf2f(za[t]), bf2f(zb[t])); bk[PHI(L + t)] = make_float2(0.f, 0.f); } }
        __syncthreads();
        fft_lds<false>(buf, N, logN, tw, tid, NBUF);
#pragma unroll
        for (int k = 0; k < NBUF; ++k) { float2* bk = buf + (size_t)k * PADN(N);
#pragma unroll 8
            for (int i = 0; i < N / NTHR; ++i) { const int p = tid + i * NTHR; bk[PHI(p)] = cmul(bk[PHI(p)], kspec[p]); } }
        __syncthreads();
        fft_lds<true>(buf, N, logN, tw, tid, NBUF);
        if (rep == FFT_REP - 1) {
#pragma unroll
        for (int k = 0; k < NBUF; ++k) { const int pr = rd * NBUF + k; const float2* bk = buf + (size_t)k * PADN(N);
            bf16* xa = xbase + ((size_t)((2 * pr) * HYW + c) * L); bf16* xb = xbase + ((size_t)((2 * pr + 1) * HYW + c) * L);
#pragma unroll
            for (int i = 0; i < (L / NTHR < 8 ? L / NTHR : 8); ++i) { const int t = tid + i * NTHR; const float2 v = bk[PHI(t)];
                xa[t] = (bf16)f2bf(bf2f(xa[t]) * (v.x * invN)); xb[t] = (bf16)f2bf(bf2f(xb[t]) * (v.y * invN)); }
            if (L / NTHR > 8) {
#pragma unroll
            for (int i = 8; i < L / NTHR; ++i) { const int t = tid + i * NTHR; const float2 v = bk[PHI(t)];
                xa[t] = (bf16)f2bf(bf2f(xa[t]) * (v.x * invN)); xb[t] = (bf16)f2bf(bf2f(xb[t]) * (v.y * invN)); } } }
        }
        __syncthreads();
    }
    }
}
#undef PHI
#undef PADN

__device__ __forceinline__ void p4_unit(Frame& F, int unit) {
    const int tid = ((int)threadIdx.x), lane = ((int)threadIdx.x & 63), wid = F.wave; const int m0 = unit * 32;
    float* tile = (float*)F.lds;
    int b, t0, L; const bf16* yb = (const bf16*)(F.out + (size_t)MT * HYW);
    if (m0 < MP) { b = m0 / LP; t0 = m0 % LP; L = LP; } else { const int mm = m0 - MP; b = mm / LS; t0 = mm % LS; L = LS; yb += (size_t)MP * HYW; }
    { const u32x4* src = (const u32x4*)(yb + ((size_t)(b * HYW + tid) * L + t0));
#pragma unroll
      for (int i = 0; i < 4; ++i) { const u32x4 v = src[i]; const unsigned w[4] = {v.x, v.y, v.z, v.w};
#pragma unroll
          for (int e = 0; e < 4; ++e) { tile[(8 * i + 2 * e) * 512 + tid] = __uint_as_float(w[e] << 16); tile[(8 * i + 2 * e + 1) * 512 + tid] = __uint_as_float(w[e] & 0xffff0000u); } } }
    __syncthreads();
    bf16* mix = (bf16*)(F.ws + WS_MIX); const float* hw = F.in[21]; const float* mw = F.in[22]; const float* ym = (const float*)(F.ws + WS_YMLA);
#pragma unroll
    for (int i = 0; i < 4; ++i) { const int tk = wid * 4 + i; const size_t m = (size_t)m0 + tk;
        { const f32x4 a = *(const f32x4*)(tile + tk * 512 + lane * 8), c = *(const f32x4*)(tile + tk * 512 + lane * 8 + 4);
          float ss = (a.x * a.x + a.y * a.y) + (a.z * a.z + a.w * a.w) + (c.x * c.x + c.y * c.y) + (c.z * c.z + c.w * c.w); ss = wave_sum(ss);
          const float r = 1.0f / sqrtf(ss * (1.0f / 512.0f) + EPS); const f32x4 wa = *(const f32x4*)(hw + lane * 8), wc = *(const f32x4*)(hw + lane * 8 + 4);
          u32x4 w; w.x = pk2(a.x * r * wa.x, a.y * r * wa.y); w.y = pk2(a.z * r * wa.z, a.w * r * wa.w); w.z = pk2(c.x * r * wc.x, c.y * r * wc.y); w.w = pk2(c.z * r * wc.z, c.w * r * wc.w);
          *(u32x4*)(mix + m * 1024 + lane * 8) = w; }
        { const f32x4 a = *(const f32x4*)(ym + m * 512 + lane * 8), c = *(const f32x4*)(ym + m * 512 + lane * 8 + 4);
          float ss = (a.x * a.x + a.y * a.y) + (a.z * a.z + a.w * a.w) + (c.x * c.x + c.y * c.y) + (c.z * c.z + c.w * c.w); ss = wave_sum(ss);
          const float r = 1.0f / sqrtf(ss * (1.0f / 512.0f) + EPS); const f32x4 wa = *(const f32x4*)(mw + lane * 8), wc = *(const f32x4*)(mw + lane * 8 + 4);
          u32x4 w; w.x = pk2(a.x * r * wa.x, a.y * r * wa.y); w.y = pk2(a.z * r * wa.z, a.w * r * wa.w); w.z = pk2(c.x * r * wc.x, c.y * r * wc.y); w.w = pk2(c.z * r * wc.z, c.w * r * wc.w);
          *(u32x4*)(mix + m * 1024 + 512 + lane * 8) = w; } }
    __syncthreads();
}
#define XB_TMO      128
#define XB_XCNT(j)  (256  + 64 * (j))
#define XB_XSUB(j)  (1280 + 64 * (j))
#define XB_XGEN(j)  (2304 + 64 * (j))
#define XB_TOP      3328
#define XB_TOPGEN   3392
#define XCD_BAR_WORDS 3456
#define XB_SPIN_CAP (1u << 18)

__device__ __forceinline__ unsigned xb_ld(unsigned* p)              { return __hip_atomic_load(p, __ATOMIC_RELAXED, __HIP_MEMORY_SCOPE_AGENT); }
__device__ __forceinline__ unsigned xb_add(unsigned* p, unsigned v) { return __hip_atomic_fetch_add(p, v, __ATOMIC_RELAXED, __HIP_MEMORY_SCOPE_AGENT); }
__device__ __forceinline__ unsigned xb_xcc_id() { return (unsigned)__builtin_amdgcn_s_getreg((3 << 11) | 20) & 0xFu; }
#define XB_SPIN(cond, bar) do { unsigned _sp = 0; while (cond) { __builtin_amdgcn_s_sleep(1); \
    if ((++_sp & 255u) == 0u) { if (xb_ld(&(bar)[XB_TMO])) break; if (_sp > XB_SPIN_CAP) { atomicAdd(&(bar)[XB_TMO], 1u); break; } } } } while (0)

struct XcdBarrier {
    unsigned* bar; unsigned x;
    volatile LAS unsigned* st;
};

__device__ __forceinline__ XcdBarrier xcd_barrier_post(unsigned* bar, volatile LAS unsigned* st) {
    XcdBarrier b; b.bar = bar; b.x = xb_xcc_id(); b.st = st;
    if (threadIdx.x == 0) (void)xb_add(&bar[XB_XCNT(b.x)], 1u);
    return b;
}
__device__ __forceinline__ void xcd_barrier_complete(unsigned* bar, unsigned x, unsigned& nloc, unsigned& nx) {
    const unsigned G = gridDim.x * gridDim.y * gridDim.z;
    unsigned sum, cnt, mine, sp = 0u;
    for (;;) {
        sum = 0u; cnt = 0u; mine = 0u;
#pragma unroll
        for (unsigned j = 0; j < 16; ++j) { const unsigned c = xb_ld(&bar[XB_XCNT(j)]); sum += c; cnt += (c > 0u) ? 1u : 0u; mine = (j == x) ? c : mine; }
        if (sum == G) break;
        __builtin_amdgcn_s_sleep(1);
        if ((++sp & 255u) == 0u) { if (xb_ld(&bar[XB_TMO])) break; if (sp > XB_SPIN_CAP) { atomicAdd(&bar[XB_TMO], 1u); break; } }
    }
    nloc = mine > 0u ? mine : 1u; nx = cnt > 0u ? cnt : 1u;
}

__device__ __forceinline__ void xcd_barrier(const XcdBarrier& b) {
    asm volatile("s_waitcnt vmcnt(0)" ::: "memory");
    __syncthreads();
    if (threadIdx.x == 0) {
        unsigned* bar = b.bar;
        __builtin_amdgcn_s_waitcnt(0);
        unsigned nloc = b.st[0], nx = b.st[1];
        if (nloc == 0u) { xcd_barrier_complete(bar, b.x, nloc, nx); b.st[0] = nloc; b.st[1] = nx; }
        const unsigned old = xb_add(&bar[XB_XSUB(b.x)], 1u);
        const unsigned gen = old / nloc;
        if (old + 1u == (gen + 1u) * nloc) {
            __builtin_amdgcn_fence(__ATOMIC_RELEASE, "agent");
            asm volatile("s_waitcnt vmcnt(0)" ::: "memory");
            const unsigned og = xb_add(&bar[XB_TOP], 1u);
            const unsigned tg = og / nx;
            if (og + 1u == (tg + 1u) * nx) xb_add(&bar[XB_TOPGEN], 1u);
            else XB_SPIN(xb_ld(&bar[XB_TOPGEN]) == tg, bar);
            __builtin_amdgcn_fence(__ATOMIC_ACQUIRE, "agent");
            xb_add(&bar[XB_XGEN(b.x)], 1u);
            asm volatile("s_waitcnt vmcnt(0)" ::: "memory");
        } else {
            XB_SPIN(xb_ld(&bar[XB_XGEN(b.x)]) == gen, bar);
            __builtin_amdgcn_fence(__ATOMIC_ACQUIRE, "agent");
            asm volatile("s_waitcnt vmcnt(0)" ::: "memory");
        }
    }
    __syncthreads();
}
constexpr int N_PHASES = 12;
#ifndef SKIPMASK
#define SKIPMASK 0
#endif
__global__ void __launch_bounds__(NTHR, 2) mk_fwd(Args args) {
    extern __shared__ __attribute__((aligned(16))) unsigned char lds[];
    Frame F;
    F.lds = lds; F.wave = __builtin_amdgcn_readfirstlane((int)threadIdx.x >> 6);
    F.G = gridDim.x; { const int bx = blockIdx.x; F.vcu = (F.G % 8 == 0) ? (bx % 8) * (F.G / 8) + bx / 8 : bx; }
#pragma unroll
    for (int i = 0; i < 30; ++i) F.in[i] = args.in[i];
    F.out = args.out; F.ws = args.ws;
    unsigned char* ws = args.ws;
    LAS unsigned char* ldsl = (LAS unsigned char*)lds;
    for (int u = (int)threadIdx.x; u < (LDS_BYTES - LDSCTL_OFF) / 4; u += NTHR) ((LAS unsigned*)(ldsl + LDSCTL_OFF))[u] = 0u;
    __syncthreads();
    const int lo = args.ph_lo, hi = args.ph_hi;
    XcdBarrier bar; bar.bar = (unsigned*)(ws + WS_CTL) + CW_BAR; bar.x = 0; bar.st = nullptr;
#if MK_COOP && MK_XCDBAR
    bar = xcd_barrier_post((unsigned*)(ws + WS_CTL) + CW_BAR, (volatile LAS unsigned*)(ldsl + MISC_OFF) + 8);
#endif
#define IN(k) (lo <= (k) && (k) < hi)
#define BOTH(k) (IN(k) && IN((k) + 1))
#if MK_COOP
#if MK_XCDBAR
#ifndef BAR_REP
#define BAR_REP 1
#endif
#define GRID_BAR(k) do { if ((k) == 0) cg::this_grid().sync(); else { for (int br_ = 0; br_ < BAR_REP; ++br_) xcd_barrier(bar); } } while (0)
#else
#define GRID_BAR(k) cg::this_grid().sync()
#endif
#else
#define GRID_BAR(k) do { } while (0)
#endif
    bf16* xb = (bf16*)(ws + WS_A);
    float* rowss1 = (float*)(ws + WS_ROWSS1); float* rowssp = (float*)(ws + WS_ROWSSP);
    bf16* hmid = (bf16*)(ws + WS_HMID);

#ifndef P0_REP
#define P0_REP 1
#endif
    if (IN(0) && !(SKIPMASK >> 0 & 1)) {
#pragma unroll 1
        for (int rep = 0; rep < P0_REP; ++rep) p0_prologue(F); if (BOTH(0)) GRID_BAR(0); }
    if (IN(1) && !(SKIPMASK >> 1 & 1)) {
        pg8::Gemm g{xb, (const bf16*)(ws + WS_WIN), MT, NIN, 1024}; pg8::StaticOrder S; S.init(MT, NIN, F.G, (int)blockIdx.x);
        pg8::EpiScaleBf16 E{(bf16*)(ws + WS_B), NIN, (const float*)(ws + WS_RSTD0)};
#ifndef P1_REP
#define P1_REP 1
#endif
#pragma unroll 1
        for (int rep = 0; rep < P1_REP; ++rep) pg8::gemm_phase<pg8::EpiScaleBf16, pg8::StaticOrder, true, true>(ldsl, g, S, E);
        if (BOTH(1)) GRID_BAR(1);
    }
    if (IN(2) && !(SKIPMASK >> 2 & 1)) {
#ifndef P2A_REP
#define P2A_REP 1
#endif
#ifndef P2B_REP
#define P2B_REP 1
#endif
#pragma unroll 1
        for (int rep = 0; rep < P2A_REP; ++rep) for (int t = F.vcu; t < MT / 192; t += F.G) p2_mla_wg(F, t);
#pragma unroll 1
        for (int rep = 0; rep < P2B_REP; ++rep) for (int u = F.vcu; u < MT / 64; u += F.G) p2_hyena_front(F, u);
        for (int u = F.vcu; u < 640; u += F.G) p2_filter_item(F, u);
        if (BOTH(2)) GRID_BAR(2);
    }
    if (IN(3) && !(SKIPMASK >> 3 & 1)) {
#ifndef ATTN_REP
#define ATTN_REP 1
#endif
#ifndef FFT_REP
#define FFT_REP 1
#endif
#pragma unroll 1
        for (int rep = 0; rep < ATTN_REP; ++rep) {
        for (int u = F.vcu; u < 1024; u += F.G) attn_unit(F, true, u >> 5, u & 31);
        for (int u = F.vcu; u < 512; u += F.G) attn_unit(F, false, u >> 3, u & 7);
        }
        for (int c = F.vcu; c < HYW; c += F.G) fft_unit<true>(F, c);
        for (int c = F.vcu; c < HYW; c += F.G) fft_unit<false>(F, c);
        if (BOTH(3)) GRID_BAR(3);
    }
    if (IN(4) && !(SKIPMASK >> 4 & 1)) {
#ifndef P4_REP
#define P4_REP 1
#endif
#pragma unroll 1
        for (int rep = 0; rep < P4_REP; ++rep) for (int u = F.vcu; u < MT / 32; u += F.G) p4_unit(F, u);
        if (BOTH(4)) GRID_BAR(4);
    }
    if (IN(5) && !(SKIPMASK >> 5 & 1)) {
        pg8::Gemm g{(const bf16*)(ws + WS_MIX), (const bf16*)(ws + WS_WOUT), MT, 1024, 1024}; pg8::StaticOrder S; S.init(MT, 1024, F.G, (int)blockIdx.x);
        pg8::EpiResBf16 E{args.in[0], args.in[1], MP, nullptr, xb, rowss1, 0};
        pg8::gemm_phase<pg8::EpiResBf16, pg8::StaticOrder, true, true>(ldsl, g, S, E);
        if (BOTH(5)) GRID_BAR(5);
    }
    if (IN(6) && !(SKIPMASK >> 6 & 1)) {
        pg8::Gemm g{xb, (const bf16*)(ws + WS_W1), MP, DFF, 1024}; pg8::StaticOrder S; S.init(MP, DFF, F.G, (int)blockIdx.x);
        pg8::EpiRelu2Bf16 E{hmid, DFF, rowss1, 0};
#ifndef P6_REP
#define P6_REP 1
#endif
#pragma unroll 1
        for (int rep = 0; rep < P6_REP; ++rep) pg8::gemm_phase<pg8::EpiRelu2Bf16, pg8::StaticOrder, true, true>(ldsl, g, S, E);
        if (BOTH(6)) GRID_BAR(6);
    }
    if (IN(7) && !(SKIPMASK >> 7 & 1)) {
        pg8::Gemm g{hmid, (const bf16*)(ws + WS_W2), MP, 1024, DFF}; pg8::StaticOrder S; S.init(MP, 1024, F.G, (int)blockIdx.x);
        pg8::EpiResBf16 E{nullptr, nullptr, 0, xb, xb, nullptr, 0};
        pg8::gemm_phase<pg8::EpiResBf16, pg8::StaticOrder, true, true>(ldsl, g, S, E);
        if (BOTH(7)) GRID_BAR(7);
    }
    if (IN(8) && !(SKIPMASK >> 8 & 1)) {
        pg8::Gemm g{xb + (size_t)MP * 1024, (const bf16*)(ws + WS_W1), MS, DFF, 1024}; pg8::StaticOrder S; S.init(MS, DFF, F.G, (int)blockIdx.x);
        pg8::EpiRelu2Bf16 E{hmid, DFF, rowss1, MP};
        pg8::gemm_phase<pg8::EpiRelu2Bf16, pg8::StaticOrder, true, true>(ldsl, g, S, E);
        if (BOTH(8)) GRID_BAR(8);
    }
    if (IN(9) && !(SKIPMASK >> 9 & 1)) {
        pg8::Gemm g{hmid, (const bf16*)(ws + WS_W2), MS, 1024, DFF}; pg8::StaticOrder S; S.init(MS, 1024, F.G, (int)blockIdx.x);
        pg8::EpiResBf16 E{nullptr, nullptr, 0, xb, xb, nullptr, MP};
        pg8::gemm_phase<pg8::EpiResBf16, pg8::StaticOrder, true, true>(ldsl, g, S, E);
        if (BOTH(9)) GRID_BAR(9);
    }
    if (IN(10) && !(SKIPMASK >> 10 & 1)) {
        pg8::Gemm g{(const bf16*)(ws + WS_PB), (const bf16*)(ws + WS_WPP), MT, 1024, PLE}; pg8::StaticOrder S; S.init(MT, 1024, F.G, (int)blockIdx.x);
        pg8::EpiBf16Ss E{(bf16*)(ws + WS_PP), 1024, rowssp};
        pg8::gemm_phase<pg8::EpiBf16Ss, pg8::StaticOrder, true, true>(ldsl, g, S, E);
        if (BOTH(10)) GRID_BAR(10);
    }
    if (IN(11) && !(SKIPMASK >> 11 & 1)) {
        pg8::Gemm g{xb, (const bf16*)(ws + WS_WG), MT, 1024, 1024}; pg8::StaticOrder S; S.init(MT, 1024, F.G, (int)blockIdx.x);
        pg8::EpiFinal E{args.out, xb, (const bf16*)(ws + WS_PP), rowssp, args.in[29]};
        pg8::gemm_phase<pg8::EpiFinal, pg8::StaticOrder, true, true>(ldsl, g, S, E);
    }
#undef IN
#undef BOTH
}

extern "C" void kernel_launch(void* const* d_in, const int* in_sizes, int n_in, void* d_out, int out_size, void* d_ws, size_t ws_size, hipStream_t stream) {
    static int grid = 0;
    if (grid == 0) {
        if (n_in != 30 || out_size != MT * DM || ws_size < WS_END) { fprintf(stderr, "kernel_launch: unexpected shapes (n_in %d out %d ws %zu)\n", n_in, out_size, ws_size); grid = -1; return; }
        int dev = 0, cus = 0, per_cu = 0;
        if (hipGetDevice(&dev) != hipSuccess || hipDeviceGetAttribute(&cus, hipDeviceAttributeMultiprocessorCount, dev) != hipSuccess) { grid = -1; return; }
        if (hipFuncSetAttribute((const void*)mk_fwd, hipFuncAttributeMaxDynamicSharedMemorySize, LDS_BYTES) != hipSuccess) { fprintf(stderr, "kernel_launch: hipFuncSetAttribute failed\n"); grid = -1; return; }
        if (hipOccupancyMaxActiveBlocksPerMultiprocessor(&per_cu, (const void*)mk_fwd, NTHR, LDS_BYTES) != hipSuccess || per_cu < 1) fprintf(stderr, "kernel_launch: occupancy query says %d\n", per_cu);
        (void)hipGetLastError();
        grid = cus;
    }
    if (grid < 0) return;
    (void)hipMemsetAsync((char*)d_ws + WS_CTL, 0, CTL_ZERO_BYTES, stream);
    Args a{};
    for (int i = 0; i < 30; ++i) a.in[i] = (const float*)d_in[i];
    a.out = (float*)d_out; a.ws = (unsigned char*)d_ws;
#if MK_COOP
    a.ph_lo = 0; a.ph_hi = N_PHASES;
    void* kargs[] = {&a};
    hipError_t e = hipLaunchCooperativeKernel((const void*)mk_fwd, dim3(grid), dim3(NTHR), kargs, LDS_BYTES, stream);
    if (e != hipSuccess) fprintf(stderr, "kernel_launch: cooperative launch failed: %s (grid %d)\n", hipGetErrorString(e), grid);
#else
    for (int p = 0; p < N_PHASES; ++p) { a.ph_lo = p; a.ph_hi = p + 1; hipLaunchKernelGGL(mk_fwd, dim3(grid), dim3(NTHR), LDS_BYTES, stream, a); }
#endif
}
```

```cpp
#include <hip/hip_runtime.h>
#include <hip/hip_cooperative_groups.h>
#include <cstdio>
#include <cstdint>
namespace cg = cooperative_groups;
#define ATTN_REP 1
#define ATT_SCHED 0
#ifndef MK_COOP
#define MK_COOP 1
#endif
#ifndef MK_XCDBAR
#define MK_XCDBAR 1
#endif
namespace pg8 {
#define PG8_LAS __attribute__((address_space(3)))
typedef unsigned short bf16_t;
typedef short bf16x8 __attribute__((ext_vector_type(8)));
typedef float f32x4 __attribute__((ext_vector_type(4)));
typedef unsigned u32x4 __attribute__((ext_vector_type(4)));
constexpr int BM = 256, BK = 64, HALF = 128, HTB = HALF * BK * 2  , STAGE_BYTES = 8 * HTB, NXCD = 8, WGM = 8;

__host__ __device__ __forceinline__ int lds_byte(int r, int c) { const int st = (r >> 4) * 2 + (c >> 5), rr = r & 15, cc = c & 31, ob = rr * 64 + cc * 2; return st * 1024 + (ob ^ (((ob >> 9) & 1) << 5)); }
__host__ __device__ __forceinline__ void stage_rc(int b, int& R, int& C) { const int st = b / 1024, sb = b % 1024, swz = sb ^ (((sb >> 9) & 1) << 5); R = (st >> 1) * 16 + swz / 64; C = (st & 1) * 32 + (swz % 64) / 2; }
__host__ __device__ __forceinline__ int perm32(int rho) { const int n = rho >> 4, i = rho & 15; return 8 * (i >> 2) + 4 * n + (i & 3); }

struct Unit { int pm, pn; };
struct Gemm { const bf16_t* A; const bf16_t* Bt; int M, N, K; };

struct StaticOrder {
    int nM, nN, nwg, G, c;
    __host__ __device__ void init(int M, int N, int G_, int c_) { nM = M / BM; nN = N / BM; nwg = nM * nN; G = G_; c = c_; }
    __host__ __device__ bool next(int i, Unit& u) const {
        const long L = (long)i * G + c; if (L >= nwg) return false;
        int wgid = (int)L; { const int q = nwg / NXCD, r = nwg % NXCD, xcd = wgid % NXCD, off = wgid / NXCD; wgid = (xcd < r ? xcd * (q + 1) : r * (q + 1) + (xcd - r) * q) + off; }
        const int nig = WGM * nN, gid = wgid / nig, fm = gid * WGM, gsz = (nM - fm) < WGM ? (nM - fm) : WGM;
        u.pm = fm + ((wgid % nig) % gsz); u.pn = (wgid % nig) / gsz; return true;
    }
    __device__ __forceinline__ void a_ready(const Unit&) const {}
    __device__ __forceinline__ void done(const Unit&) const {}
};

__device__ __forceinline__ unsigned cvt_pk_bf16(float lo, float hi) { unsigned r; asm volatile("v_cvt_pk_bf16_f32 %0, %1, %2" : "=v"(r) : "v"(lo), "v"(hi)); return r; }
typedef float f32x2 __attribute__((ext_vector_type(2)));
template <class Epi, class Sched, bool ALIGN_EPI = false, bool SP2 = false>
__device__ __forceinline__ void gemm_phase(PG8_LAS unsigned char* lds, const Gemm g, const Sched& S, const Epi& E) {
    const int tid = threadIdx.x, wid = __builtin_amdgcn_readfirstlane(tid >> 6), lane = tid & 63, wr = wid >> 2, wc = wid & 3, fr = lane & 15, fq = lane >> 4;
    const int K = g.K, nt = K / BK;
    unsigned voffA[2], voffB[2];
#pragma unroll
    for (int i = 0; i < 2; ++i) { int R, C; stage_rc(tid * 16 + i * 8192, R, C); const int Rb = Epi::PERM ? ((R & ~31) + perm32(R & 31)) : R;
        voffA[i] = (unsigned)(R * K + C) * 2u; voffB[i] = (unsigned)(Rb * K + C) * 2u; }
    const size_t kstep = (size_t)(BK * 2);
    const size_t hstep = (size_t)HALF * K * 2;
    const size_t tstep = 2 * hstep;
    const unsigned ldsw = (unsigned)wid * 1024u;
    const int aoff = lds_byte(wr * 64 + fr, fq * 8), boff = lds_byte(wc * 32 + fr, fq * 8);
#define PG8_SA(b, h) (((b) * 2 + (h)) * HTB)
#define PG8_SB(b, h) ((4 + (b) * 2 + (h)) * HTB)
#define PG8_STAGE(bufoff, gbase, voff) do { _Pragma("unroll") for (int _i = 0; _i < 2; ++_i) \
        __builtin_amdgcn_global_load_lds((const unsigned*)((const char*)(gbase) + (voff)[_i]), (PG8_LAS unsigned*)(lds + (bufoff) + ldsw + _i * 8192), 16, 0, 0); } while (0)
#define PG8_LDA(dst, b, h) do { _Pragma("unroll") for (int m = 0; m < 4; ++m) _Pragma("unroll") for (int k = 0; k < 2; ++k) dst[m][k] = *(const PG8_LAS bf16x8*)(lds + PG8_SA(b, h) + aoff + m * 2048 + k * 1024); } while (0)
#define PG8_LDB(dst, b, h) do { _Pragma("unroll") for (int n = 0; n < 2; ++n) _Pragma("unroll") for (int k = 0; k < 2; ++k) dst[n][k] = *(const PG8_LAS bf16x8*)(lds + PG8_SB(b, h) + boff + n * 2048 + k * 1024); } while (0)
#define PG8_MMA(ai, bj, At, Bt) do { __builtin_amdgcn_s_setprio(1); _Pragma("unroll") for (int m = 0; m < 4; ++m) _Pragma("unroll") for (int n = 0; n < 2; ++n) _Pragma("unroll") for (int k = 0; k < 2; ++k) \
        acc[ai][bj][m][n] = __builtin_amdgcn_mfma_f32_16x16x32_bf16(Bt[n][k], At[m][k], acc[ai][bj][m][n], 0, 0, 0); __builtin_amdgcn_s_setprio(0); } while (0)
#define PG8_WAIT_V(n) asm volatile("s_waitcnt vmcnt(" #n ")" ::: "memory")
#define PG8_WAIT_L(n) asm volatile("s_waitcnt lgkmcnt(" #n ")" ::: "memory")
#define PG8_BAR __builtin_amdgcn_s_barrier()
#define PG8_SCHED __builtin_amdgcn_sched_barrier(0)
    Unit cur, nxt; int ui = 0;
    if (!S.next(0, cur)) return;
    f32x4 acc[2][2][4][2];
#pragma unroll
    for (int a = 0; a < 2; ++a)
#pragma unroll
        for (int b = 0; b < 2; ++b)
#pragma unroll
            for (int m = 0; m < 4; ++m)
#pragma unroll
                for (int n = 0; n < 2; ++n) acc[a][b][m][n] = (f32x4){0.f, 0.f, 0.f, 0.f};
    bf16x8 At[4][2], B0[2][2], B1[2][2];
    const char* cA = (const char*)g.A + (size_t)cur.pm * tstep; const char* cB = (const char*)g.Bt + (size_t)cur.pn * tstep;
    S.a_ready(cur);
    if constexpr (SP2) {
        PG8_STAGE(PG8_SB(0, 0), cB, voffB); PG8_STAGE(PG8_SB(0, 1), cB + hstep, voffB); PG8_STAGE(PG8_SA(0, 0), cA, voffA); PG8_STAGE(PG8_SA(0, 1), cA + hstep, voffA);
        if (wr == 1) PG8_BAR;
        PG8_WAIT_V(2); PG8_BAR;
        PG8_STAGE(PG8_SB(1, 0), cB + kstep, voffB); PG8_STAGE(PG8_SA(1, 0), cA + kstep, voffA); PG8_STAGE(PG8_SB(1, 1), cB + hstep + kstep, voffB);
        PG8_WAIT_V(6); PG8_BAR;
    } else {
        PG8_STAGE(PG8_SB(0, 0), cB, voffB); PG8_STAGE(PG8_SA(0, 0), cA, voffA); PG8_STAGE(PG8_SB(0, 1), cB + hstep, voffB); PG8_STAGE(PG8_SA(0, 1), cA + hstep, voffA);
        if (wr == 1) PG8_BAR;
        PG8_WAIT_V(4); PG8_BAR;
        PG8_STAGE(PG8_SB(1, 0), cB + kstep, voffB); PG8_STAGE(PG8_SA(1, 0), cA + kstep, voffA); PG8_STAGE(PG8_SB(1, 1), cB + hstep + kstep, voffB);
        PG8_WAIT_V(6); PG8_BAR;
    }
    for (;;) {
        const bool has_next = S.next(ui + 1, nxt);
        const char* nA = has_next ? (const char*)g.A + (size_t)nxt.pm * tstep : cA; const char* nB = has_next ? (const char*)g.Bt + (size_t)nxt.pn * tstep : cB;
        for (int t = 0; t < nt; t += 2) {
            const bool last = (t == nt - 2);
            const char* a1 = cA + (size_t)(t + 1) * kstep;
            const char* a2 = last ? nA : cA + (size_t)(t + 2) * kstep; const char* b2 = last ? nB : cB + (size_t)(t + 2) * kstep;
            const char* a3 = a2 + kstep; const char* b3 = b2 + kstep;
            if (last && has_next) S.a_ready(nxt);
            if constexpr (SP2) {
            PG8_LDB(B0, 0, 0); PG8_LDB(B1, 0, 1); PG8_SCHED; PG8_LDA(At, 0, 0); PG8_STAGE(PG8_SA(1, 1), a1 + hstep, voffA);
            PG8_WAIT_V(8); PG8_WAIT_L(0); PG8_BAR; PG8_MMA(0, 0, At, B0); PG8_MMA(0, 1, At, B1); PG8_BAR; PG8_SCHED;
            PG8_LDA(At, 0, 1); PG8_STAGE(PG8_SB(0, 0), b2, voffB); PG8_STAGE(PG8_SB(0, 1), b2 + hstep, voffB); PG8_STAGE(PG8_SA(0, 0), a2, voffA);
            PG8_WAIT_V(8); PG8_WAIT_L(0); PG8_BAR; PG8_MMA(1, 0, At, B0); PG8_MMA(1, 1, At, B1); PG8_BAR; PG8_SCHED;
            PG8_LDB(B0, 1, 0); PG8_LDB(B1, 1, 1); PG8_SCHED; PG8_LDA(At, 1, 0); PG8_STAGE(PG8_SA(0, 1), a2 + hstep, voffA);
            PG8_WAIT_V(8); PG8_WAIT_L(0); PG8_BAR; PG8_MMA(0, 0, At, B0); PG8_MMA(0, 1, At, B1); PG8_BAR; PG8_SCHED;
            PG8_LDA(At, 1, 1); PG8_STAGE(PG8_SB(1, 0), b3, voffB); PG8_STAGE(PG8_SB(1, 1), b3 + hstep, voffB); PG8_STAGE(PG8_SA(1, 0), a3, voffA);
            PG8_WAIT_V(8); PG8_WAIT_L(0); PG8_BAR; PG8_MMA(1, 0, At, B0); PG8_MMA(1, 1, At, B1); PG8_BAR; PG8_SCHED;
            } else {
            PG8_LDB(B0, 0, 0); PG8_SCHED; PG8_LDA(At, 0, 0); PG8_STAGE(PG8_SA(1, 1), a1 + hstep, voffA);
            PG8_WAIT_L(8); PG8_BAR; PG8_WAIT_L(0); PG8_MMA(0, 0, At, B0); PG8_BAR; PG8_SCHED;
            PG8_LDB(B1, 0, 1); PG8_STAGE(PG8_SB(0, 0), b2, voffB);
            PG8_BAR; PG8_WAIT_L(0); PG8_MMA(0, 1, At, B1); PG8_BAR;
            PG8_LDA(At, 0, 1); PG8_STAGE(PG8_SA(0, 0), a2, voffA);
            PG8_BAR; PG8_WAIT_L(0); PG8_MMA(1, 0, At, B0); PG8_BAR; PG8_SCHED;
            PG8_STAGE(PG8_SB(0, 1), b2 + hstep, voffB);
            PG8_WAIT_V(6); PG8_BAR; PG8_MMA(1, 1, At, B1); PG8_BAR;
            PG8_LDB(B0, 1, 0); PG8_SCHED; PG8_LDA(At, 1, 0); PG8_STAGE(PG8_SA(0, 1), a2 + hstep, voffA);
            PG8_WAIT_L(8); PG8_BAR; PG8_WAIT_L(0); PG8_MMA(0, 0, At, B0); PG8_BAR; PG8_SCHED;
            PG8_LDB(B1, 1, 1); PG8_STAGE(PG8_SB(1, 0), b3, voffB);
            PG8_BAR; PG8_WAIT_L(0); PG8_MMA(0, 1, At, B1); PG8_BAR;
            PG8_LDA(At, 1, 1); PG8_STAGE(PG8_SA(1, 0), a3, voffA);
            PG8_BAR; PG8_WAIT_L(0); PG8_MMA(1, 0, At, B0); PG8_BAR; PG8_SCHED;
            PG8_STAGE(PG8_SB(1, 1), b3 + hstep, voffB);
            PG8_WAIT_V(6); PG8_BAR; PG8_MMA(1, 1, At, B1); PG8_BAR;
            }
        }
        if constexpr (ALIGN_EPI) { if (wr == 0) PG8_BAR; }
        if constexpr (!Epi::AFTER_DRAIN) { E(acc, cur, wr, wc, fr, fq); S.done(cur); }
        if (!has_next) break;
#pragma unroll
        for (int a = 0; a < 2; ++a)
#pragma unroll
            for (int b = 0; b < 2; ++b)
#pragma unroll
                for (int m = 0; m < 4; ++m)
#pragma unroll
                    for (int n = 0; n < 2; ++n) acc[a][b][m][n] = (f32x4){0.f, 0.f, 0.f, 0.f};
        cur = nxt; cA = nA; cB = nB; ++ui;
        if constexpr (ALIGN_EPI) { if (wr == 1) PG8_BAR; }
    }
    PG8_WAIT_V(0);
    if constexpr (!ALIGN_EPI) { if (wr == 0) PG8_BAR; }
    PG8_BAR;
    if constexpr (Epi::AFTER_DRAIN) { E.fused(acc, cur, wr, wc, fr, fq, lds, wid, lane); S.done(cur); }
#undef PG8_SA
#undef PG8_SB
#undef PG8_STAGE
#undef PG8_LDA
#undef PG8_LDB
#undef PG8_MMA
#undef PG8_WAIT_V
#undef PG8_WAIT_L
#undef PG8_BAR
#undef PG8_SCHED
}
}
namespace pg8 {
typedef unsigned u32x2 __attribute__((ext_vector_type(2)));
constexpr float RMS_EPS = 1e-6f;
struct EpiScaleBf16 {
    static constexpr bool PERM = true, AFTER_DRAIN = false;
    bf16_t* O; int ldc; const float* rstd;
    __device__ __forceinline__ void operator()(const f32x4 (&acc)[2][2][4][2], const Unit& u, int wr, int wc, int fr, int fq) const {
        const int row0 = u.pm * BM + wr * 64 + fr, col0 = u.pn * BM + wc * 32 + 8 * fq;
#pragma unroll
        for (int ai = 0; ai < 2; ++ai)
#pragma unroll
            for (int m = 0; m < 4; ++m) { const int row = row0 + ai * HALF + m * 16; const float s = rstd[row]; bf16_t* rowp = O + (size_t)row * ldc + col0;
#pragma unroll
                for (int bj = 0; bj < 2; ++bj) { const f32x4 v0 = acc[ai][bj][m][0] * s, v1 = acc[ai][bj][m][1] * s; u32x4 w;
                    w.x = cvt_pk_bf16(v0[0], v0[1]); w.y = cvt_pk_bf16(v0[2], v0[3]); w.z = cvt_pk_bf16(v1[0], v1[1]); w.w = cvt_pk_bf16(v1[2], v1[3]);
                    *(u32x4*)(rowp + bj * HALF) = w; } }
    }
};
struct EpiRelu2Bf16 {
    static constexpr bool PERM = true, AFTER_DRAIN = false;
    bf16_t* O; int ldc; const float* rowss; int row_off;
    __device__ __forceinline__ void operator()(const f32x4 (&acc)[2][2][4][2], const Unit& u, int wr, int wc, int fr, int fq) const {
        const int row0 = u.pm * BM + wr * 64 + fr, col0 = u.pn * BM + wc * 32 + 8 * fq;
#pragma unroll
        for (int ai = 0; ai < 2; ++ai)
#pragma unroll
            for (int m = 0; m < 4; ++m) { const int row = row0 + ai * HALF + m * 16; const float s = __builtin_amdgcn_rsqf(rowss[row_off + row] * (1.0f / 1024.0f) + RMS_EPS); bf16_t* rowp = O + (size_t)row * ldc + col0;
#pragma unroll
                for (int bj = 0; bj < 2; ++bj) { f32x4 v0 = acc[ai][bj][m][0] * s, v1 = acc[ai][bj][m][1] * s;
#pragma unroll
                    for (int e = 0; e < 4; ++e) { const float a = fmaxf(v0[e], 0.f), b = fmaxf(v1[e], 0.f); v0[e] = a * a; v1[e] = b * b; }
                    u32x4 w; w.x = cvt_pk_bf16(v0[0], v0[1]); w.y = cvt_pk_bf16(v0[2], v0[3]); w.z = cvt_pk_bf16(v1[0], v1[1]); w.w = cvt_pk_bf16(v1[2], v1[3]);
                    *(u32x4*)(rowp + bj * HALF) = w; } }
    }
};
struct EpiResF32 {
    static constexpr bool PERM = false, AFTER_DRAIN = false;
    const float* r0; const float* r1; int split; float* out; bf16_t* ob; float* rowss; int row_off;
    __device__ __forceinline__ void operator()(const f32x4 (&acc)[2][2][4][2], const Unit& u, int wr, int wc, int fr, int fq) const {
        const int col0 = u.pn * BM + wc * 32 + 4 * fq;
#pragma unroll
        for (int ai = 0; ai < 2; ++ai) {
            f32x4 pre[4][2][2];
#pragma unroll
            for (int m = 0; m < 4; ++m) { const int row = row_off + u.pm * BM + ai * HALF + wr * 64 + m * 16 + fr;
                const float* rr = (row < split) ? r0 + (size_t)row * 1024 : r1 + (size_t)(row - split) * 1024;
#pragma unroll
                for (int bj = 0; bj < 2; ++bj)
#pragma unroll
                    for (int n = 0; n < 2; ++n) pre[m][bj][n] = *(const f32x4*)(rr + col0 + bj * HALF + n * 16); }
            asm volatile("" ::: "memory");
#pragma unroll
            for (int m = 0; m < 4; ++m) { const int row = row_off + u.pm * BM + ai * HALF + wr * 64 + m * 16 + fr; float ss = 0.f;
#pragma unroll
                for (int bj = 0; bj < 2; ++bj)
#pragma unroll
                    for (int n = 0; n < 2; ++n) { const int col = col0 + bj * HALF + n * 16; const f32x4 v = pre[m][bj][n] + acc[ai][bj][m][n];
                        *(f32x4*)(out + (size_t)row * 1024 + col) = v; u32x2 w; w.x = cvt_pk_bf16(v[0], v[1]); w.y = cvt_pk_bf16(v[2], v[3]); *(u32x2*)(ob + (size_t)row * 1024 + col) = w;
                        ss += (v[0] * v[0] + v[1] * v[1]) + (v[2] * v[2] + v[3] * v[3]); }
                if (rowss) { ss += __shfl_xor(ss, 16); ss += __shfl_xor(ss, 32); if (fq == 0) atomicAdd(rowss + row, ss); } }
        }
    }
};
struct EpiResBf16 {
    static constexpr bool PERM = true, AFTER_DRAIN = false;
    const float* r0; const float* r1; int split; const bf16_t* rb; bf16_t* ob; float* rowss; int row_off;
    __device__ __forceinline__ void operator()(const f32x4 (&acc)[2][2][4][2], const Unit& u, int wr, int wc, int fr, int fq) const {
        const int col0 = u.pn * BM + wc * 32 + 8 * fq;
#pragma unroll
        for (int ai = 0; ai < 2; ++ai) {
            f32x4 pre[4][2][2];
#pragma unroll
            for (int m = 0; m < 4; ++m) { const int row = row_off + u.pm * BM + ai * HALF + wr * 64 + m * 16 + fr;
                if (rb) {
#pragma unroll
                    for (int bj = 0; bj < 2; ++bj) { const u32x4 w = *(const u32x4*)(rb + (size_t)row * 1024 + col0 + bj * HALF);
                        pre[m][bj][0] = (f32x4){__uint_as_float(w.x << 16), __uint_as_float(w.x & 0xffff0000u), __uint_as_float(w.y << 16), __uint_as_float(w.y & 0xffff0000u)};
                        pre[m][bj][1] = (f32x4){__uint_as_float(w.z << 16), __uint_as_float(w.z & 0xffff0000u), __uint_as_float(w.w << 16), __uint_as_float(w.w & 0xffff0000u)}; }
                } else { const float* rr = (row < split) ? r0 + (size_t)row * 1024 : r1 + (size_t)(row - split) * 1024;
#pragma unroll
                    for (int bj = 0; bj < 2; ++bj)
#pragma unroll
                        for (int n = 0; n < 2; ++n) pre[m][bj][n] = *(const f32x4*)(rr + col0 + bj * HALF + n * 4); } }
            asm volatile("" ::: "memory");
#pragma unroll
            for (int m = 0; m < 4; ++m) { const int row = row_off + u.pm * BM + ai * HALF + wr * 64 + m * 16 + fr; float ss = 0.f;
#pragma unroll
                for (int bj = 0; bj < 2; ++bj) { const f32x4 v0 = pre[m][bj][0] + acc[ai][bj][m][0], v1 = pre[m][bj][1] + acc[ai][bj][m][1];
                    u32x4 w; w.x = cvt_pk_bf16(v0[0], v0[1]); w.y = cvt_pk_bf16(v0[2], v0[3]); w.z = cvt_pk_bf16(v1[0], v1[1]); w.w = cvt_pk_bf16(v1[2], v1[3]);
                    *(u32x4*)(ob + (size_t)row * 1024 + col0 + bj * HALF) = w;
                    ss += (v0[0] * v0[0] + v0[1] * v0[1]) + (v0[2] * v0[2] + v0[3] * v0[3]) + (v1[0] * v1[0] + v1[1] * v1[1]) + (v1[2] * v1[2] + v1[3] * v1[3]); }
                if (rowss) { ss += __shfl_xor(ss, 16); ss += __shfl_xor(ss, 32); if (fq == 0) atomicAdd(rowss + row, ss); } }
        }
    }
};
struct EpiBf16Ss {
    static constexpr bool PERM = true, AFTER_DRAIN = false;
    bf16_t* O; int ldc; float* rowss;
    __device__ __forceinline__ void operator()(const f32x4 (&acc)[2][2][4][2], const Unit& u, int wr, int wc, int fr, int fq) const {
        const int row0 = u.pm * BM + wr * 64 + fr, col0 = u.pn * BM + wc * 32 + 8 * fq;
#pragma unroll
        for (int ai = 0; ai < 2; ++ai)
#pragma unroll
            for (int m = 0; m < 4; ++m) { const int row = row0 + ai * HALF + m * 16; bf16_t* rowp = O + (size_t)row * ldc + col0; float ss = 0.f;
#pragma unroll
                for (int bj = 0; bj < 2; ++bj) { const f32x4 v0 = acc[ai][bj][m][0], v1 = acc[ai][bj][m][1]; u32x4 w;
                    w.x = cvt_pk_bf16(v0[0], v0[1]); w.y = cvt_pk_bf16(v0[2], v0[3]); w.z = cvt_pk_bf16(v1[0], v1[1]); w.w = cvt_pk_bf16(v1[2], v1[3]);
                    *(u32x4*)(rowp + bj * HALF) = w;
                    ss += (v0[0] * v0[0] + v0[1] * v0[1]) + (v0[2] * v0[2] + v0[3] * v0[3]) + (v1[0] * v1[0] + v1[1] * v1[1]) + (v1[2] * v1[2] + v1[3] * v1[3]); }
                ss += __shfl_xor(ss, 16); ss += __shfl_xor(ss, 32); if (fq == 0) atomicAdd(rowss + row, ss); }
    }
};
struct EpiFinal {
    static constexpr bool PERM = false, AFTER_DRAIN = false;
    float* out; const bf16_t* xr; const bf16_t* pp; const float* rowssp; const float* pw;
    __device__ __forceinline__ void operator()(const f32x4 (&acc)[2][2][4][2], const Unit& u, int wr, int wc, int fr, int fq) const {
        const int col0 = u.pn * BM + wc * 32 + 4 * fq;
#pragma unroll
        for (int ai = 0; ai < 2; ++ai)
#pragma unroll
            for (int m = 0; m < 4; ++m) { const int row = u.pm * BM + ai * HALF + wr * 64 + m * 16 + fr; const float s = __builtin_amdgcn_rsqf(rowssp[row] * (1.0f / 1024.0f) + RMS_EPS);
#pragma unroll
                for (int bj = 0; bj < 2; ++bj)
#pragma unroll
                    for (int n = 0; n < 2; ++n) { const int col = col0 + bj * HALF + n * 16; const size_t off = (size_t)row * 1024 + col;
                        const u32x2 xw = *(const u32x2*)(xr + off); const f32x4 x = (f32x4){__uint_as_float(xw.x << 16), __uint_as_float(xw.x & 0xffff0000u), __uint_as_float(xw.y << 16), __uint_as_float(xw.y & 0xffff0000u)}; const f32x4 w = *(const f32x4*)(pw + col); const u32x2 pb = *(const u32x2*)(pp + off); const f32x4 g = acc[ai][bj][m][n];
                        f32x4 p; p[0] = __uint_as_float(pb.x << 16); p[1] = __uint_as_float(pb.x & 0xffff0000u); p[2] = __uint_as_float(pb.y << 16); p[3] = __uint_as_float(pb.y & 0xffff0000u);
                        f32x4 o;
#pragma unroll
                        for (int e = 0; e < 4; ++e) { const float sg = 1.0f / (1.0f + __expf(-g[e])); o[e] = x[e] + sg * p[e] * s * w[e]; }
                        *(f32x4*)(out + off) = o; } }
    }
};
}
#define GAS __attribute__((address_space(1)))
#define LAS __attribute__((address_space(3)))
typedef unsigned short bf16;
typedef float f32x4 __attribute__((ext_vector_type(4)));
typedef float f32x16 __attribute__((ext_vector_type(16)));
typedef short bf16x8 __attribute__((ext_vector_type(8)));
typedef short s16x4 __attribute__((ext_vector_type(4)));
typedef unsigned u32x4 __attribute__((ext_vector_type(4)));
typedef unsigned u32x2 __attribute__((ext_vector_type(2)));
constexpr int DM = 1024, LP = 8192, BP = 4, LS = 2048, BS = 8, MP = BP * LP, MS = BS * LS, MT = MP + MS;
constexpr int NIN = 2048, IN_COLS = 1952, HYW = 512, QLORA = 256, KVLORA = 128, NH = 8, QKD = 96, DFF = 4096, PLE = 256;
constexpr int COL_Q = 1536, COL_KV = 1792, COL_KR = 1920;
constexpr float EPS = 1e-6f;
constexpr float QSCALE = 0.10206207261596575f * 1.4426950408889634f;
constexpr int NWAVES = 8, NTHR = 512;
constexpr int KVT_BYTES = 20480, KT_BYTES = 12288;
constexpr size_t QS_OFF = (size_t)32 * LP * QKD;
constexpr size_t KVS_OFF = (size_t)32 * (LP / 64) * KVT_BYTES;
constexpr size_t MiB = 1u << 20;
constexpr size_t WS_CTL = 0, CTL_ZERO_BYTES = 1 * MiB;
constexpr size_t WS_ROWSS1 = 256 * 1024, WS_ROWSSP = 512 * 1024;
constexpr size_t WS_RSTD0 = 1 * MiB, WS_TW = 1 * MiB + 256 * 1024, WS_ROPE = 2 * MiB, WS_H2P = 3 * MiB, WS_H2S = 5 * MiB + 512 * 1024;
constexpr size_t WS_WIN = 8 * MiB, WS_WQB = 12 * MiB, WS_WKVB = 12 * MiB + 512 * 1024, WS_WOUT = 13 * MiB, WS_W1 = 15 * MiB, WS_W2 = 23 * MiB, WS_WG = 31 * MiB, WS_WPP = 33 * MiB;
constexpr size_t WS_PB = 34 * MiB;
constexpr size_t WS_A = 58 * MiB;
constexpr size_t WS_B = 154 * MiB;
constexpr size_t WS_YMLA = WS_B, WS_MIX = WS_B + 96 * MiB, WS_KSPEC = WS_MIX, WS_HMID = WS_B, WS_PP = WS_B + 128 * MiB;
constexpr size_t WS_C = 346 * MiB;
constexpr size_t WS_KERNP = 466 * MiB, WS_KERNS = 498 * MiB;
constexpr size_t WS_END = 506 * MiB;
constexpr int CW_BAR = 4096;
static_assert((16384 + 16384 / 16) * 8 <= 131072 + 8192 && 4 * (4096 + 4096 / 16) * 8 <= 131072 + 8192, "padded FFT image must end below the LDS control words");
constexpr int RING_BYTES = 131072, LDSX_OFF = RING_BYTES  , LDSCTL_OFF = RING_BYTES + 8192, MISC_OFF = LDSCTL_OFF + 320, LDS_BYTES = 147456;

#define LDS_WAIT() asm volatile("s_waitcnt lgkmcnt(0)" ::: "memory")
#define VM_WAIT() asm volatile("s_waitcnt vmcnt(0)" ::: "memory")
__device__ __forceinline__ unsigned f2bf(float f) { unsigned u = __builtin_bit_cast(unsigned, f); return (u + 0x7fffu + ((u >> 16) & 1u)) >> 16; }
__device__ __forceinline__ unsigned pk2(float lo, float hi) { return f2bf(lo) | (f2bf(hi) << 16); }
__device__ __forceinline__ float bf2f(unsigned h) { return __uint_as_float(h << 16); }
__device__ __forceinline__ float wave_sum(float v) {
#pragma unroll
    for (int o = 1; o < 64; o <<= 1) v += __shfl_xor(v, o);
    return v;
}
__device__ __forceinline__ int crow(int r, int hi) { return (r & 3) + 8 * (r >> 2) + 4 * hi; }
__device__ __forceinline__ float fadd_s(float a, float b) { float r; asm("v_add_f32_e32 %0, %1, %2" : "=v"(r) : "v"(a), "v"(b)); return r; }
__device__ __forceinline__ float fsub_s(float a, float b) { float r; asm("v_sub_f32_e32 %0, %1, %2" : "=v"(r) : "v"(a), "v"(b)); return r; }
__device__ __forceinline__ float fmul_s(float a, float b) { float r; asm("v_mul_f32_e32 %0, %1, %2" : "=v"(r) : "v"(a), "v"(b)); return r; }
__device__ __forceinline__ float ffma_s(float a, float b, float c) { float r; asm("v_fma_f32 %0, %1, %2, %3" : "=v"(r) : "v"(a), "v"(b), "v"(c)); return r; }
__device__ __forceinline__ float ffms_s(float a, float b, float c) { float r; asm("v_fma_f32 %0, %1, %2, -%3" : "=v"(r) : "v"(a), "v"(b), "v"(c)); return r; }

struct Args { const float* in[30]; float* out; unsigned char* ws; int ph_lo, ph_hi; };
struct Frame {
    unsigned char* lds;
    int wave, vcu, G;
    const float* in[30]; float* out; unsigned char* ws;
};
__device__ __forceinline__ const float* xrow(const Frame& F, int m) { return m < MP ? F.in[0] + (size_t)m * DM : F.in[1] + (size_t)(m - MP) * DM; }
__device__ __forceinline__ const float* prow(const Frame& F, int m) { return m < MP ? F.in[2] + (size_t)m * PLE : F.in[3] + (size_t)(m - MP) * PLE; }

__device__ __forceinline__ void p0_transpose_item(const float* W, int K, int N, bf16* WT, const float* sc, float* scr, int item, int lane, int R = 0) {
    const int nblk = N / 32, kb = item / nblk, nb = item % nblk, k0 = 64 * kb, n0 = 32 * nb;
#pragma unroll
    for (int i = 0; i < 32; ++i) { const int kk = 2 * i + (lane >> 5); float v = W[(size_t)(k0 + kk) * N + n0 + (lane & 31)]; if (sc) v *= sc[k0 + kk]; scr[kk * 33 + (lane & 31)] = v; }
    LDS_WAIT(); asm volatile("" ::: "memory");
    const int c = lane & 7;
#pragma unroll
    for (int j = 0; j < 4; ++j) { const int n = (lane >> 3) + 8 * j; const float* s = scr + (8 * c) * 33 + n;
        u32x4 o; o.x = pk2(s[0 * 33], s[1 * 33]); o.y = pk2(s[2 * 33], s[3 * 33]); o.z = pk2(s[4 * 33], s[5 * 33]); o.w = pk2(s[6 * 33], s[7 * 33]);
        if (R == 0) *(u32x4*)(WT + (size_t)(n0 + n) * K + k0 + 8 * c) = o;
        else { const int nn = n0 + n, h = nn / R, ft = (nn % R) >> 5, r32 = nn & 31, kc = (k0 >> 3) + c, ks = kc >> 1, hh = kc & 1, nks = K >> 4;
            *(u32x4*)(WT + ((size_t)(((h * (R >> 5) + ft) * nks + ks) * 64 + hh * 32 + r32)) * 8) = o; } }
    LDS_WAIT(); asm volatile("" ::: "memory");
}
__device__ __forceinline__ void p0_prologue(Frame& F) {
    float* scr = (float*)(F.lds + F.wave * 16384);
    const int gw = F.vcu * NWAVES + F.wave, NGW = F.G * NWAVES, lane = ((int)threadIdx.x & 63);
    unsigned char* ws = F.ws;
    constexpr int I_IN = 16 * 61, I_QB = 4 * 24, I_KVB = 2 * 32, I_OUT = 16 * 32, I_1 = 16 * 128, I_2 = 64 * 32, I_G = 16 * 32, I_PP = 4 * 32;
    constexpr int NITEMS = I_IN + I_QB + I_KVB + I_OUT + I_1 + I_2 + I_G + I_PP;
    for (int it = gw; it < NITEMS; it += NGW) {
        int r = it;
        if (r < I_IN) { p0_transpose_item(F.in[5], 1024, IN_COLS, (bf16*)(ws + WS_WIN), F.in[4], scr, r, lane); continue; } r -= I_IN;
        if (r < I_QB) { p0_transpose_item(F.in[16], QLORA, 768, (bf16*)(ws + WS_WQB), F.in[15], scr, r, lane, QKD); continue; } r -= I_QB;
        if (r < I_KVB) { p0_transpose_item(F.in[18], KVLORA, 1024, (bf16*)(ws + WS_WKVB), F.in[17], scr, r, lane, 128); continue; } r -= I_KVB;
        if (r < I_OUT) { p0_transpose_item(F.in[23], 1024, 1024, (bf16*)(ws + WS_WOUT), nullptr, scr, r, lane); continue; } r -= I_OUT;
        if (r < I_1) { p0_transpose_item(F.in[25], 1024, DFF, (bf16*)(ws + WS_W1), F.in[24], scr, r, lane); continue; } r -= I_1;
        if (r < I_2) { p0_transpose_item(F.in[26], DFF, 1024, (bf16*)(ws + WS_W2), nullptr, scr, r, lane); continue; } r -= I_2;
        if (r < I_G) { p0_transpose_item(F.in[27], 1024, 1024, (bf16*)(ws + WS_WG), nullptr, scr, r, lane); continue; } r -= I_G;
        p0_transpose_item(F.in[28], PLE, 1024, (bf16*)(ws + WS_WPP), nullptr, scr, r, lane);
    }
    { u32x4* z = (u32x4*)(ws + WS_WIN + (size_t)IN_COLS * 1024 * 2); const int n16 = (NIN - IN_COLS) * 1024 * 2 / 16;
      for (int i = (F.vcu * NTHR + ((int)threadIdx.x)); i < n16; i += F.G * NTHR) z[i] = (u32x4){0u, 0u, 0u, 0u}; }
    bf16* xb = (bf16*)(ws + WS_A); float* rstd0 = (float*)(ws + WS_RSTD0); bf16* pb = (bf16*)(ws + WS_PB);
#pragma unroll 8
    for (int m = gw; m < MT; m += NGW) {
        const f32x4* xr = (const f32x4*)xrow(F, m) + lane; f32x4 v[4]; float s = 0.f;
#pragma unroll
        for (int j = 0; j < 4; ++j) { v[j] = xr[64 * j]; s += (v[j].x * v[j].x + v[j].y * v[j].y) + (v[j].z * v[j].z + v[j].w * v[j].w); }
        s = wave_sum(s);
        if (lane == 0) rstd0[m] = 1.0f / sqrtf(s * (1.0f / DM) + EPS);
        u32x2* o8 = (u32x2*)(xb + (size_t)m * DM) + lane;
#pragma unroll
        for (int j = 0; j < 4; ++j) { u32x2 w; w.x = pk2(v[j].x, v[j].y); w.y = pk2(v[j].z, v[j].w); o8[64 * j] = w; }
        const f32x4 pv = ((const f32x4*)prow(F, m))[lane]; u32x2 w; w.x = pk2(pv.x, pv.y); w.y = pk2(pv.z, pv.w); ((u32x2*)(pb + (size_t)m * PLE))[lane] = w;
    }
    { float2* tw = (float2*)(ws + WS_TW); float2* rope = (float2*)(ws + WS_ROPE);
      for (int i = F.vcu * NTHR + ((int)threadIdx.x); i < 16384; i += F.G * NTHR) { float sn, cs; sincospif((float)i * (1.0f / 8192.0f), &sn, &cs); tw[i] = make_float2(cs, -sn); }
      for (int i = F.vcu * NTHR + ((int)threadIdx.x); i < LP * 16; i += F.G * NTHR) { const int t = i >> 4, k = i & 15; const float inv = powf(10000.0f, -(2.0f * (float)k) / 32.0f); const float ang = (float)t * inv;
          float sn, cs; sincosf(ang, &sn, &cs); rope[i] = make_float2(cs, sn); } }
    { const float* w1 = F.in[8]; const float* b1 = F.in[9]; const float* fq = F.in[10]; const float* w2 = F.in[11]; const float* b2 = F.in[12];
      const float freq = fq[lane], bb1 = b1[lane], bb2 = b2[lane];
      for (int pos = gw; pos < LP + LS; pos += NGW) {
          const int L = pos < LP ? LP : LS, j = pos < LP ? pos : pos - LP;
          const float t = (float)j * (1.0f / (float)(L - 1)); const float w = (6.283185307179586f * (float)j) / (float)L;
          float zv = 0.f;
          if (lane == 0) zv = t;
          else if (lane <= 16) { const float f = 1e-4f + (float)(lane - 1) * ((15.0f - 1e-4f) / 15.0f); zv = cosf(f * w); }
          else if (lane <= 32) { const float f = 1e-4f + (float)(lane - 17) * ((15.0f - 1e-4f) / 15.0f); zv = -sinf(f * w); }
          float a1 = bb1;
          for (int i = 0; i < 33; ++i) a1 += __shfl(zv, i) * w1[i * 64 + lane];
          const float h1 = sinf(freq * a1);
          float a2 = bb2;
          for (int k = 0; k < 64; ++k) a2 += __shfl(h1, k) * w2[k * 64 + lane];
          const float h2 = sinf(freq * a2);
          float* dst = (pos < LP) ? (float*)(ws + WS_H2P) + (size_t)lane * LP + j : (float*)(ws + WS_H2S) + (size_t)lane * LS + j;
          *dst = h2;
      } }
}

__device__ __forceinline__ void p2_mla_tile(Frame& F, int tile) {
    const int lane = ((int)threadIdx.x & 63), wid = F.wave, r32 = lane & 31, hi = lane >> 5;
    unsigned char* lds = F.lds;
    unsigned char* LQ = lds; unsigned char* LKV = lds + 32768; unsigned char* LKR = lds + 49152; float* RS = (float*)(lds + 53248);
    const bf16* proj = (const bf16*)(F.ws + WS_B);
    const int m0 = tile * 64;
#pragma unroll 2
    for (int i = 0; i < 8; ++i) { const int tok = wid * 8 + i; float ss = 0.f;
        if (lane < 52) { const u32x4 v = *(const u32x4*)(proj + (size_t)(m0 + tok) * NIN + COL_Q + lane * 8);
            const unsigned w[4] = {v.x, v.y, v.z, v.w};
#pragma unroll
            for (int e = 0; e < 4; ++e) { const float a = __uint_as_float(w[e] << 16), b = __uint_as_float(w[e] & 0xffff0000u); ss += a * a + b * b; }
            unsigned char* dst = lane < 32 ? LQ + (lane * 64 + tok) * 16 : (lane < 48 ? LKV + ((lane - 32) * 64 + tok) * 16 : LKR + tok * 64 + (lane - 48) * 16);
            *(u32x4*)dst = v; }
        const float sq = wave_sum(lane < 32 ? ss : 0.f), skv = wave_sum((lane >= 32 && lane < 48) ? ss : 0.f);
        if (lane == 0) { RS[tok] = 1.0f / sqrtf(sq * (1.0f / QLORA) + EPS); RS[64 + tok] = 1.0f / sqrtf(skv * (1.0f / KVLORA) + EPS); } }
    __syncthreads();
    int b, t0, L; size_t qoff; size_t kvoff;
    if (m0 < MP) { b = m0 / LP; t0 = m0 % LP; L = LP; qoff = ((size_t)(b * NH + wid) * LP + t0) * QKD; kvoff = ((size_t)(b * NH + wid) * (LP / 64) + t0 / 64) * KVT_BYTES; }
    else { const int mm = m0 - MP; b = mm / LS; t0 = mm % LS; L = LS; qoff = QS_OFF + ((size_t)(b * NH + wid) * LS + t0) * QKD; kvoff = KVS_OFF + ((size_t)(b * NH + wid) * (LS / 64) + t0 / 64) * KVT_BYTES; }
    (void)L;
    const float2* rope = (const float2*)(F.ws + WS_ROPE);
#pragma unroll 1
    for (int tb = 0; tb < 2; ++tb) {
        const bf16* wq = (const bf16*)(F.ws + WS_WQB) + ((size_t)(wid * 3) * 16 * 64 + lane) * 8;
        const int tok = tb * 32 + r32;
        f32x16 acc[3];
#pragma unroll
        for (int a = 0; a < 3; ++a) acc[a] = (f32x16){};
#pragma unroll 2
        for (int ks = 0; ks < 16; ++ks) {
            const bf16x8 b0 = *(const bf16x8*)(LQ + ((2 * ks + hi) * 64 + tok) * 16);
#pragma unroll
            for (int ft = 0; ft < 3; ++ft) { const bf16x8 a = *(const bf16x8*)(wq + (size_t)((ft * 16 + ks) * 64) * 8);
                acc[ft] = __builtin_amdgcn_mfma_f32_32x32x16_bf16(a, b0, acc[ft], 0, 0, 0); }
        }
        const float* qnw = F.in[19];
        bf16* qr = (bf16*)(F.ws + WS_A) + qoff + (size_t)tok * QKD;
        const float s = RS[tok]; float ss = 0.f;
#pragma unroll
        for (int ft = 0; ft < 3; ++ft)
#pragma unroll
            for (int r = 0; r < 16; ++r) { const float v = acc[ft][r] * s; acc[ft][r] = v; ss += v * v; }
        ss += __shfl_xor(ss, 32);
        const float rq = 1.0f / sqrtf(ss * (1.0f / QKD) + EPS);
#pragma unroll
        for (int ft = 0; ft < 3; ++ft)
#pragma unroll
            for (int r = 0; r < 16; ++r) acc[ft][r] *= rq * qnw[32 * ft + crow(r, hi)];
#pragma unroll
        for (int r = 0; r < 8; ++r) { const float2 cs = rope[(size_t)(t0 + tok) * 16 + crow(r, hi)]; const float a = acc[2][r], bq = acc[2][r + 8];
            acc[2][r] = a * cs.x - bq * cs.y; acc[2][r + 8] = a * cs.y + bq * cs.x; }
#pragma unroll
        for (int ft = 0; ft < 3; ++ft)
#pragma unroll
            for (int g = 0; g < 4; ++g) { u32x2 w; w.x = pk2(acc[ft][4 * g] * QSCALE, acc[ft][4 * g + 1] * QSCALE); w.y = pk2(acc[ft][4 * g + 2] * QSCALE, acc[ft][4 * g + 3] * QSCALE);
                *(u32x2*)(qr + 32 * ft + 8 * g + 4 * hi) = w; }
    }
#pragma unroll 1
    for (int it = 0; it < 4; ++it) {
        const int half = it >> 1, tb = it & 1, tok = tb * 32 + r32;
        const bf16* wkv = (const bf16*)(F.ws + WS_WKVB) + ((size_t)((wid * 4 + half * 2) * 8) * 64 + lane) * 8;
        const float* knw = F.in[20];
        unsigned char* KT = F.ws + WS_C + kvoff;
        f32x16 acc[2];
        acc[0] = (f32x16){}; acc[1] = (f32x16){};
#pragma unroll 2
        for (int ks = 0; ks < 8; ++ks) {
            const bf16x8 b0 = *(const bf16x8*)(LKV + ((2 * ks + hi) * 64 + tok) * 16);
#pragma unroll
            for (int ft = 0; ft < 2; ++ft) { const bf16x8 a = *(const bf16x8*)(wkv + (size_t)((ft * 8 + ks) * 64) * 8);
                acc[ft] = __builtin_amdgcn_mfma_f32_32x32x16_bf16(a, b0, acc[ft], 0, 0, 0); }
        }
        const float s = RS[64 + tok];
        if (half == 0) {
            float ss = 0.f;
#pragma unroll
            for (int ft = 0; ft < 2; ++ft)
#pragma unroll
                for (int r = 0; r < 16; ++r) { const float v = acc[ft][r] * s; acc[ft][r] = v; ss += v * v; }
            const u32x4 ka = *(const u32x4*)(LKR + tok * 64 + hi * 16), kb = *(const u32x4*)(LKR + tok * 64 + 32 + hi * 16);
            float fa[8], fb[8]; { const unsigned wa[4] = {ka.x, ka.y, ka.z, ka.w}, wb[4] = {kb.x, kb.y, kb.z, kb.w};
#pragma unroll
                for (int e = 0; e < 4; ++e) { fa[2 * e] = __uint_as_float(wa[e] << 16); fa[2 * e + 1] = __uint_as_float(wa[e] & 0xffff0000u); fb[2 * e] = __uint_as_float(wb[e] << 16); fb[2 * e + 1] = __uint_as_float(wb[e] & 0xffff0000u); } }
#pragma unroll
            for (int j = 0; j < 8; ++j) ss += fa[j] * fa[j] + fb[j] * fb[j];
            ss += __shfl_xor(ss, 32);
            const float rk = 1.0f / sqrtf(ss * (1.0f / QKD) + EPS);
#pragma unroll
            for (int ft = 0; ft < 2; ++ft)
#pragma unroll
                for (int g = 0; g < 4; ++g) { float v[4];
#pragma unroll
                    for (int e = 0; e < 4; ++e) v[e] = acc[ft][4 * g + e] * rk * knw[32 * ft + 8 * g + 4 * hi + e];
                    u32x2 w; w.x = pk2(v[0], v[1]); w.y = pk2(v[2], v[3]);
                    *(u32x2*)(KT + (((4 * ft + g) * 64 + tok) * 8 + 4 * hi) * 2) = w; }
            { float oa[8], ob[8];
#pragma unroll
              for (int j = 0; j < 8; ++j) { const int i = 8 * hi + j; const float2 cs = rope[(size_t)(t0 + tok) * 16 + i]; const float a = fa[j] * rk * knw[64 + i], bq = fb[j] * rk * knw[80 + i];
                  oa[j] = a * cs.x - bq * cs.y; ob[j] = a * cs.y + bq * cs.x; }
              u32x4 wa, wb; wa.x = pk2(oa[0], oa[1]); wa.y = pk2(oa[2], oa[3]); wa.z = pk2(oa[4], oa[5]); wa.w = pk2(oa[6], oa[7]); wb.x = pk2(ob[0], ob[1]); wb.y = pk2(ob[2], ob[3]); wb.z = pk2(ob[4], ob[5]); wb.w = pk2(ob[6], ob[7]);
              *(u32x4*)(KT + ((8 + hi) * 64 + tok) * 16) = wa; *(u32x4*)(KT + ((10 + hi) * 64 + tok) * 16) = wb; }
        } else {
#pragma unroll
            for (int ft = 0; ft < 2; ++ft)
#pragma unroll
                for (int g = 0; g < 4; ++g) { u32x2 w; w.x = pk2(acc[ft][4 * g] * s, acc[ft][4 * g + 1] * s); w.y = pk2(acc[ft][4 * g + 2] * s, acc[ft][4 * g + 3] * s);
                    *(u32x2*)(KT + KT_BYTES + ((ft * 64 + tok) * 32 + 8 * g + 4 * hi) * 2) = w; }
        }
    }
    __syncthreads();
}
__device__ __forceinline__ void p2_mla_wg(Frame& F, int u) {
    const int tid = (int)threadIdx.x, lane = tid & 63, wid = F.wave, r32 = lane & 31, hi = lane >> 5;
    unsigned char* lds = F.lds;
    const bf16* proj = (const bf16*)(F.ws + WS_B);
    const bool comp = wid < 6;
    const int mb = u * 192 + (comp ? wid : 0) * 32;
    int b, t0, L; size_t qbase, kvbase;
    if (mb < MP) { b = mb / LP; t0 = mb % LP; L = LP; qbase = (size_t)(b * NH) * LP * QKD; kvbase = (size_t)(b * NH) * (LP / 64) * KVT_BYTES; }
    else { const int mm = mb - MP; b = mm / LS; t0 = mm % LS; L = LS; qbase = QS_OFF + (size_t)(b * NH) * LS * QKD; kvbase = KVS_OFF + (size_t)(b * NH) * (LS / 64) * KVT_BYTES; }
    const int tk = (t0 & 63) + r32;
    const float2* rope = (const float2*)(F.ws + WS_ROPE);
    int hi8 = 8 * hi; asm volatile("" : "+v"(hi8));
    const bf16* row = proj + (size_t)(mb + r32) * NIN + hi8;
    const float* qnw = F.in[19]; const float* knw = F.in[20];
    const unsigned lds0 = (unsigned)(uintptr_t)lds;
#define P2_GLDS(gsrc_, ldst_) do { unsigned keep_; asm volatile("s_mov_b32 %0, m0\n\ts_mov_b32 m0, %2\n\ts_nop 0\n\tglobal_load_lds_dwordx4 %1, off\n\ts_mov_b32 m0, %0" : "=&s"(keep_) : "v"(gsrc_), "s"(ldst_) : "memory"); } while (0)
#define P2_DMA(ci_) do { const int c_ = (ci_); const int np_ = c_ < 8 ? 6 : 4; unsigned lo2_ = (unsigned)lane * 16u; asm volatile("" : "+v"(lo2_)); \
        const unsigned char* g_ = chunk_src(c_) + wid * 1024 + lo2_; const unsigned l_ = (unsigned)__builtin_amdgcn_readfirstlane((int)(lds0 + (c_ & 1) * 49152 + wid * 1024)); \
        _Pragma("unroll") for (int j_ = 0; j_ < 6; ++j_) if (j_ < np_) P2_GLDS(g_ + j_ * 8192, l_ + (unsigned)(j_ * 8192)); } while (0)
    auto chunk_src = [&](int i) -> const unsigned char* { return i < 8 ? F.ws + WS_WQB + (size_t)i * 49152 : F.ws + WS_WKVB + (size_t)(i - 8) * 32768; };
    float* nwl = (float*)(lds + 98304);
    if (tid < 96) nwl[tid] = qnw[tid]; else if (tid < 192) nwl[tid] = knw[tid - 96];
    P2_DMA(0);
    asm volatile("s_waitcnt vmcnt(0)" ::: "memory");
    __syncthreads();
    {
        bf16x8 bq[16]; float rsq; float2 ropq[8];
#pragma unroll
        for (int r = 0; r < 8; ++r) ropq[r] = rope[(size_t)(t0 + r32) * 16 + crow(r, hi)];
        { float sq = 0.f;
#pragma unroll
          for (int ks = 0; ks < 16; ++ks) { bq[ks] = *(const bf16x8*)(row + COL_Q + 16 * ks);
#pragma unroll
              for (int j = 0; j < 8; ++j) { const float v = bf2f((unsigned short)bq[ks][j]); sq += v * v; } }
          sq += __shfl_xor(sq, 32); rsq = 1.0f / sqrtf(sq * (1.0f / QLORA) + EPS); }
#pragma unroll 1
        for (int i = 0; i < 8; ++i) {
            const unsigned char* wl = lds + (i & 1) * 49152;
            P2_DMA(i + 1);
            if (comp) {
                unsigned lo_ = (unsigned)lane * 16u; asm volatile("" : "+v"(lo_)); const unsigned char* wll = wl + lo_;
                const int h = i; f32x16 acc[3];
#pragma unroll
                for (int a = 0; a < 3; ++a) acc[a] = (f32x16){};
#pragma unroll
                for (int ks = 0; ks < 16; ++ks) {
#pragma unroll
                    for (int ft = 0; ft < 3; ++ft) { const bf16x8 a = *(const bf16x8*)(wll + ((ft * 16 + ks) * 64) * 16); acc[ft] = __builtin_amdgcn_mfma_f32_32x32x16_bf16(a, bq[ks], acc[ft], 0, 0, 0); }
                    if ((ks & 3) == 3) __builtin_amdgcn_sched_barrier(0);
                }
                float ss = 0.f;
#pragma unroll
                for (int ft = 0; ft < 3; ++ft)
#pragma unroll
                    for (int r = 0; r < 16; ++r) { const float v = acc[ft][r] * rsq; acc[ft][r] = v; ss += v * v; }
                ss += __shfl_xor(ss, 32);
                const float rq = 1.0f / sqrtf(ss * (1.0f / QKD) + EPS);
#pragma unroll
                for (int ft = 0; ft < 3; ++ft)
#pragma unroll
                    for (int g = 0; g < 4; ++g) { const f32x4 w4 = *(const f32x4*)(nwl + 32 * ft + 8 * g + 4 * hi);
#pragma unroll
                        for (int e2 = 0; e2 < 4; ++e2) acc[ft][4 * g + e2] *= rq * w4[e2]; }
#pragma unroll
                for (int r = 0; r < 8; ++r) { const float2 cs = ropq[r]; const float a = acc[2][r], bqv = acc[2][r + 8];
                    acc[2][r] = a * cs.x - bqv * cs.y; acc[2][r + 8] = a * cs.y + bqv * cs.x; }
                bf16* qr = (bf16*)(F.ws + WS_A) + qbase + ((size_t)h * L + t0 + r32) * QKD;
#pragma unroll
                for (int ft = 0; ft < 3; ++ft)
#pragma unroll
                    for (int g = 0; g < 4; ++g) { u32x2 w; w.x = pk2(acc[ft][4 * g] * QSCALE, acc[ft][4 * g + 1] * QSCALE); w.y = pk2(acc[ft][4 * g + 2] * QSCALE, acc[ft][4 * g + 3] * QSCALE);
                        *(u32x2*)(qr + 32 * ft + 8 * g + 4 * hi) = w; }
            }
            asm volatile("s_waitcnt vmcnt(0)" ::: "memory");
            __syncthreads();
        }
    }
    {
        bf16x8 bkv[8]; float rskv; float fa[8], fb[8]; float ssr = 0.f; float2 ropk[8];
#pragma unroll
        for (int j = 0; j < 8; ++j) ropk[j] = rope[(size_t)(t0 + r32) * 16 + 8 * hi + j];
        { float skv = 0.f;
#pragma unroll
          for (int ks = 0; ks < 8; ++ks) { bkv[ks] = *(const bf16x8*)(row + COL_KV + 16 * ks);
#pragma unroll
              for (int j = 0; j < 8; ++j) { const float v = bf2f((unsigned short)bkv[ks][j]); skv += v * v; } }
          skv += __shfl_xor(skv, 32); rskv = 1.0f / sqrtf(skv * (1.0f / KVLORA) + EPS);
          const u32x4 kra = *(const u32x4*)(row + COL_KR), krb = *(const u32x4*)(row + COL_KR + 16);
          const unsigned wa[4] = {kra.x, kra.y, kra.z, kra.w}, wb[4] = {krb.x, krb.y, krb.z, krb.w};
#pragma unroll
          for (int e = 0; e < 4; ++e) { fa[2 * e] = __uint_as_float(wa[e] << 16); fa[2 * e + 1] = __uint_as_float(wa[e] & 0xffff0000u); fb[2 * e] = __uint_as_float(wb[e] << 16); fb[2 * e + 1] = __uint_as_float(wb[e] & 0xffff0000u); }
#pragma unroll
          for (int j = 0; j < 8; ++j) ssr += fa[j] * fa[j] + fb[j] * fb[j]; }
#pragma unroll 1
        for (int i = 8; i < 16; ++i) {
            const unsigned char* wl = lds + (i & 1) * 49152;
            if (i + 1 < 16) P2_DMA(i + 1);
            if (comp) {
                unsigned lo_ = (unsigned)lane * 16u; asm volatile("" : "+v"(lo_)); const unsigned char* wll = wl + lo_;
                const int h = i - 8; f32x16 acc[4]; const float* knl = nwl + 96;
#pragma unroll
                for (int a = 0; a < 4; ++a) acc[a] = (f32x16){};
#pragma unroll
                for (int ks = 0; ks < 8; ++ks) {
#pragma unroll
                    for (int ft = 0; ft < 4; ++ft) { const bf16x8 a = *(const bf16x8*)(wll + ((ft * 8 + ks) * 64) * 16); acc[ft] = __builtin_amdgcn_mfma_f32_32x32x16_bf16(a, bkv[ks], acc[ft], 0, 0, 0); }
                    if ((ks & 1) == 1) __builtin_amdgcn_sched_barrier(0);
                }
                unsigned char* KT = F.ws + WS_C + kvbase + ((size_t)h * (L / 64) + (t0 >> 6)) * KVT_BYTES;
                float ss = ssr;
#pragma unroll
                for (int ft = 0; ft < 2; ++ft)
#pragma unroll
                    for (int r = 0; r < 16; ++r) { const float v = acc[ft][r] * rskv; acc[ft][r] = v; ss += v * v; }
                ss += __shfl_xor(ss, 32);
                const float rk = 1.0f / sqrtf(ss * (1.0f / QKD) + EPS);
#pragma unroll
                for (int ft = 0; ft < 2; ++ft)
#pragma unroll
                    for (int g = 0; g < 4; ++g) { float v[4]; const f32x4 w4 = *(const f32x4*)(knl + 32 * ft + 8 * g + 4 * hi);
#pragma unroll
                        for (int e = 0; e < 4; ++e) v[e] = acc[ft][4 * g + e] * rk * w4[e];
                        u32x2 w; w.x = pk2(v[0], v[1]); w.y = pk2(v[2], v[3]);
                        *(u32x2*)(KT + (((4 * ft + g) * 64 + tk) * 8 + 4 * hi) * 2) = w; }
                { float oa[8], ob[8];
#pragma unroll
                  for (int j = 0; j < 8; ++j) { const int ii = 8 * hi + j; const float2 cs = ropk[j]; const float a = fa[j] * rk * knl[64 + ii], bqv = fb[j] * rk * knl[80 + ii];
                      oa[j] = a * cs.x - bqv * cs.y; ob[j] = a * cs.y + bqv * cs.x; }
                  u32x4 wa2, wb2; wa2.x = pk2(oa[0], oa[1]); wa2.y = pk2(oa[2], oa[3]); wa2.z = pk2(oa[4], oa[5]); wa2.w = pk2(oa[6], oa[7]); wb2.x = pk2(ob[0], ob[1]); wb2.y = pk2(ob[2], ob[3]); wb2.z = pk2(ob[4], ob[5]); wb2.w = pk2(ob[6], ob[7]);
                  *(u32x4*)(KT + ((8 + hi) * 64 + tk) * 16) = wa2; *(u32x4*)(KT + ((10 + hi) * 64 + tk) * 16) = wb2; }
#pragma unroll
                for (int ft = 2; ft < 4; ++ft)
#pragma unroll
                    for (int g = 0; g < 4; ++g) { u32x2 w; w.x = pk2(acc[ft][4 * g] * rskv, acc[ft][4 * g + 1] * rskv); w.y = pk2(acc[ft][4 * g + 2] * rskv, acc[ft][4 * g + 3] * rskv);
                        *(u32x2*)(KT + KT_BYTES + (((ft - 2) * 64 + tk) * 32 + 8 * g + 4 * hi) * 2) = w; }
            }
            asm volatile("s_waitcnt vmcnt(0)" ::: "memory");
            __syncthreads();
        }
    }
}
#undef P2_GLDS
#undef P2_DMA
__device__ __forceinline__ void p2_hyena_front(Frame& F, int unit) {
    const int c = ((int)threadIdx.x); const int m0 = unit * 32;
    int b, t0, L; bf16* zt; bf16* x0t;
    bf16* zbase = (bf16*)F.out; bf16* xbase = (bf16*)(F.out + (size_t)MT * HYW);
    if (m0 < MP) { b = m0 / LP; t0 = m0 % LP; L = LP; zt = zbase + ((size_t)(b * HYW + c) * LP + t0); x0t = xbase + ((size_t)(b * HYW + c) * LP + t0); }
    else { const int mm = m0 - MP; b = mm / LS; t0 = mm % LS; L = LS; zt = zbase + (size_t)MP * HYW + ((size_t)(b * HYW + c) * LS + t0); x0t = xbase + (size_t)MP * HYW + ((size_t)(b * HYW + c) * LS + t0); }
    const bf16* proj = (const bf16*)(F.ws + WS_B) + (size_t)(m0 - t0) * NIN;
    const float* cw = F.in[6]; const float* cb = F.in[7];
    float w0[3], w1[3], w2[3], bb[3];
#pragma unroll
    for (int s = 0; s < 3; ++s) { w0[s] = cw[0 * 1536 + s * 512 + c]; w1[s] = cw[1 * 1536 + s * 512 + c]; w2[s] = cw[2 * 1536 + s * 512 + c]; bb[s] = cb[s * 512 + c]; }
    float pv[3], cv[3], nv[3];
    auto ld = [&](int t, float (&d)[3]) { const bool ok = (t >= 0) && (t < L); const int tc = t < 0 ? 0 : (t >= L ? L - 1 : t); const bf16* r = proj + (size_t)tc * NIN + c;
        const float a0 = bf2f(r[0]), a1 = bf2f(r[512]), a2 = bf2f(r[1024]); d[0] = ok ? a0 : 0.f; d[1] = ok ? a1 : 0.f; d[2] = ok ? a2 : 0.f; };
    ld(t0 - 1, pv); ld(t0, cv);
    float zo[32], xo[32];
#pragma unroll
    for (int i = 0; i < 32; ++i) { ld(t0 + i + 1, nv);
        float u[3];
#pragma unroll
        for (int s = 0; s < 3; ++s) u[s] = bb[s] + pv[s] * w0[s] + cv[s] * w1[s] + nv[s] * w2[s];
        xo[i] = u[0]; zo[i] = u[2] * u[1];
#pragma unroll
        for (int s = 0; s < 3; ++s) { pv[s] = cv[s]; cv[s] = nv[s]; } }
#pragma unroll
    for (int i = 0; i < 4; ++i) { u32x4 w; w.x = pk2(zo[8 * i], zo[8 * i + 1]); w.y = pk2(zo[8 * i + 2], zo[8 * i + 3]); w.z = pk2(zo[8 * i + 4], zo[8 * i + 5]); w.w = pk2(zo[8 * i + 6], zo[8 * i + 7]); ((u32x4*)zt)[i] = w; }
#pragma unroll
    for (int i = 0; i < 4; ++i) { u32x4 w; w.x = pk2(xo[8 * i], xo[8 * i + 1]); w.y = pk2(xo[8 * i + 2], xo[8 * i + 3]); w.z = pk2(xo[8 * i + 4], xo[8 * i + 5]); w.w = pk2(xo[8 * i + 6], xo[8 * i + 7]); ((u32x4*)x0t)[i] = w; }
}

__device__ __forceinline__ void p2_filter_item(Frame& F, int item) {
    const int tid = (int)threadIdx.x;
    const bool prompt = item < 512; const int it = prompt ? item : item - 512;
    const int L = prompt ? LP : LS; const int cg = prompt ? (it >> 2) : it, pc = prompt ? (it & 3) : 0;
    const int c0 = cg * 8, j4 = pc * 2048 + tid * 4;
    const float* h2 = (const float*)(F.ws + (prompt ? WS_H2P : WS_H2S)); const float* w3 = F.in[13] + c0;
    float* kern = (float*)(F.ws + (prompt ? WS_KERNP : WS_KERNS));
    f32x4 acc[8];
#pragma unroll
    for (int c = 0; c < 8; ++c) acc[c] = (f32x4){0.f, 0.f, 0.f, 0.f};
#pragma unroll 8
    for (int k = 0; k < 64; ++k) { const f32x4 hv = *(const f32x4*)(h2 + (size_t)k * L + j4); const f32x4 wa = *(const f32x4*)(w3 + k * 1024), wb = *(const f32x4*)(w3 + k * 1024 + 4);
        acc[0] += hv * wa.x; acc[1] += hv * wa.y; acc[2] += hv * wa.z; acc[3] += hv * wa.w; acc[4] += hv * wb.x; acc[5] += hv * wb.y; acc[6] += hv * wb.z; acc[7] += hv * wb.w; }
    const float min_decay = -15.350567286626973f, max_decay = -3.0701134573253945f; const float rl = 1.0f / (float)(L - 1);
#pragma unroll
    for (int c = 0; c < 8; ++c) { const int ch = (c0 + c) & 511; const float delta = fabsf(min_decay + (float)ch * ((max_decay - min_decay) / 511.0f)); f32x4 o;
#pragma unroll
        for (int e = 0; e < 4; ++e) o[e] = acc[c][e] * expf(-((float)(j4 + e) * rl) * delta);
        *(f32x4*)(kern + (size_t)(c0 + c) * L + j4) = o; }
}

__device__ __forceinline__ s16x4 vtr(const unsigned char* p) { typedef short v4i16_t __attribute__((ext_vector_type(4)));
    return __builtin_bit_cast(s16x4, __builtin_amdgcn_ds_read_tr16_b64_v4i16((LAS v4i16_t*)p)); }
__device__ __forceinline__ unsigned cvtpk(float lo, float hi) { typedef float f2 __attribute__((ext_vector_type(2))); typedef __bf16 b2 __attribute__((ext_vector_type(2))); f2 v = {lo, hi}; b2 r = __builtin_convertvector(v, b2); return __builtin_bit_cast(unsigned, r); }
__device__ __forceinline__ float max3f(float a, float b, float c) { float r; asm("v_max3_f32 %0, %1, %2, %3" : "=v"(r) : "v"(a), "v"(b), "v"(c)); return r; }
typedef float f32x2a __attribute__((ext_vector_type(2)));
#ifndef ATT_SCHED
#define ATT_SCHED 1
#endif
#ifndef ATT_THR
#define ATT_THR 8.0f
#endif
#ifndef ATT_TRACK_LIMIT
#define ATT_TRACK_LIMIT 4.0f
#endif
template <bool LAST> __device__ __forceinline__ void attn_step(f32x16& p0, f32x16& p1, f32x16& q0, f32x16& q1, f32x16& o0, f32x16& o1, float& mrun, float& lsum, f32x16& negm, const bool track, const bf16x8 (&qr)[6],
        const unsigned char* lds, int t, int NT, const unsigned char* KV, int tid, int r32, int hi, int voff) {
    const int cur = t % 3, nxt = (t + 1) % 3, nn = (t + 2) % 3;
    u32x4 s0, s1, s2 = (u32x4){0u, 0u, 0u, 0u};
    if (!LAST) { const int tl = (t + 2 < NT) ? t + 2 : NT - 1; const u32x4* src = (const u32x4*)(KV + (size_t)tl * KVT_BYTES); s0 = src[tid]; s1 = src[tid + 512]; if (tid < 256) s2 = src[tid + 1024]; }
    const unsigned char* kb = lds + nxt * KVT_BYTES;
    const unsigned char* vb = lds + cur * KVT_BYTES + KT_BYTES + voff;
    bf16x8 kf[12];
    if (!LAST) {
#pragma unroll
        for (int d = 0; d < 6; ++d) { kf[2 * d] = *(const bf16x8*)(kb + ((2 * d + hi) * 64 + r32) * 16); kf[2 * d + 1] = *(const bf16x8*)(kb + ((2 * d + hi) * 64 + 32 + r32) * 16); }
    }
    s16x4 va[8], vc[8];
#pragma unroll
    for (int s = 0; s < 4; ++s) { va[2 * s] = vtr(vb + s * 1024); va[2 * s + 1] = vtr(vb + s * 1024 + 512); vc[2 * s] = vtr(vb + 4096 + s * 1024); vc[2 * s + 1] = vtr(vb + 4096 + s * 1024 + 512); }
    if (!LAST) {
        q0 = __builtin_amdgcn_mfma_f32_32x32x16_bf16(kf[0], qr[0], negm, 0, 0, 0); q1 = __builtin_amdgcn_mfma_f32_32x32x16_bf16(kf[1], qr[0], negm, 0, 0, 0);
#pragma unroll
        for (int d = 1; d < 6; ++d) { q0 = __builtin_amdgcn_mfma_f32_32x32x16_bf16(kf[2 * d], qr[d], q0, 0, 0, 0); q1 = __builtin_amdgcn_mfma_f32_32x32x16_bf16(kf[2 * d + 1], qr[d], q1, 0, 0, 0); }
    }
    if (track) {
        float mx = max3f(p0[0], p0[1], p1[0]);
#pragma unroll
        for (int r = 2; r < 16; r += 2) mx = max3f(mx, p0[r], p0[r + 1]);
#pragma unroll
        for (int r = 1; r < 15; r += 2) mx = max3f(mx, p1[r], p1[r + 1]);
        mx = fmaxf(mx, p1[15]);
        { auto rr = __builtin_amdgcn_permlane32_swap(__float_as_uint(mx), __float_as_uint(mx), false, false); mx = fmaxf(__uint_as_float(rr[0]), __uint_as_float(rr[1])); }
        if (__any(mx > ATT_THR)) {
            const float dl = fmaxf(mx, 0.f); mrun += dl; const float alpha = __builtin_amdgcn_exp2f(-dl); lsum *= alpha;
#pragma unroll
            for (int r = 0; r < 16; ++r) { p0[r] -= dl; p1[r] -= dl; o0[r] *= alpha; o1[r] *= alpha; negm[r] = -mrun; }
            if (!LAST) {
#pragma unroll
                for (int r = 0; r < 16; ++r) { q0[r] -= dl; q1[r] -= dl; }
            }
        }
    }
    float psa = 0.f, psb = 0.f;
#pragma unroll
    for (int r = 0; r < 16; ++r) { p0[r] = __builtin_amdgcn_exp2f(p0[r]); p1[r] = __builtin_amdgcn_exp2f(p1[r]); psa += p0[r]; psb += p1[r]; }
    lsum += (psa + psb);
    u32x4 pw[4];
#pragma unroll
    for (int s = 0; s < 4; ++s) { const int bse = 8 * (s & 1);
        if (s < 2) pw[s] = (u32x4){cvtpk(p0[bse], p0[bse + 1]), cvtpk(p0[bse + 2], p0[bse + 3]), cvtpk(p0[bse + 4], p0[bse + 5]), cvtpk(p0[bse + 6], p0[bse + 7])};
        else pw[s] = (u32x4){cvtpk(p1[bse], p1[bse + 1]), cvtpk(p1[bse + 2], p1[bse + 3]), cvtpk(p1[bse + 4], p1[bse + 5]), cvtpk(p1[bse + 6], p1[bse + 7])}; }
#if ATT_SCHED
    if (!LAST) {
#pragma unroll
        for (int i = 0; i < 12; ++i) { __builtin_amdgcn_sched_group_barrier(0x008, 1, 0); __builtin_amdgcn_sched_group_barrier(0x002, 12, 0); }
    }
#endif
#pragma unroll
    for (int s = 0; s < 4; ++s) {
        const s16x4 a0 = va[2 * s], a1 = va[2 * s + 1], c0 = vc[2 * s], c1 = vc[2 * s + 1];
        const bf16x8 v0 = (bf16x8){a0[0], a0[1], a0[2], a0[3], a1[0], a1[1], a1[2], a1[3]}, v1 = (bf16x8){c0[0], c0[1], c0[2], c0[3], c1[0], c1[1], c1[2], c1[3]};
        const bf16x8 pf = __builtin_bit_cast(bf16x8, pw[s]);
        o0 = __builtin_amdgcn_mfma_f32_32x32x16_bf16(v0, pf, o0, 0, 0, 0); o1 = __builtin_amdgcn_mfma_f32_32x32x16_bf16(v1, pf, o1, 0, 0, 0);
    }
    if (!LAST) { u32x4* dst = (u32x4*)(lds + nn * KVT_BYTES); dst[tid] = s0; dst[tid + 512] = s1; if (tid < 256) dst[tid + 1024] = s2; }
    __syncthreads();
}
__device__ __forceinline__ void attn_unit(Frame& F, bool prompt, int bh, int qb) {
    const int tid = ((int)threadIdx.x), lane = ((int)threadIdx.x & 63), wid = F.wave, r32 = lane & 31, hi = lane >> 5;
    const int L = prompt ? LP : LS, NT = L / 64;
    const bf16* Qg = (const bf16*)(F.ws + WS_A) + (prompt ? 0 : QS_OFF) + ((size_t)bh * L + qb * 256 + wid * 32 + r32) * QKD + hi * 8;
    const unsigned char* KV = F.ws + WS_C + (prompt ? 0 : KVS_OFF) + (size_t)bh * NT * KVT_BYTES;
    unsigned char* lds = F.lds;
    bf16x8 qr[6];
#pragma unroll
    for (int d = 0; d < 6; ++d) qr[d] = *(const bf16x8*)(Qg + d * 16);
    f32x16 o0 = (f32x16){}, o1 = (f32x16){}; float mrun = 0.f, lsum = 0.f;
    { const u32x4* src = (const u32x4*)KV; u32x4* dst = (u32x4*)lds;
#pragma unroll
      for (int j = 0; j < 2; ++j) { const u32x4 a = src[j * 1280 + tid], b = src[j * 1280 + tid + 512]; u32x4 c = (u32x4){0u, 0u, 0u, 0u}; if (tid < 256) c = src[j * 1280 + tid + 1024];
          dst[j * 1280 + tid] = a; dst[j * 1280 + tid + 512] = b; if (tid < 256) dst[j * 1280 + tid + 1024] = c; } }
    __syncthreads();
    const int voff = (4 * hi + ((lane & 15) >> 2)) * 64 + ((lane >> 4) & 1) * 32 + (lane & 3) * 8;
    f32x16 pa0 = (f32x16){}, pa1 = (f32x16){}, pb0, pb1;
#pragma unroll
    for (int d = 0; d < 6; ++d) {
        const bf16x8 k0 = *(const bf16x8*)(lds + ((2 * d + hi) * 64 + r32) * 16), k1 = *(const bf16x8*)(lds + ((2 * d + hi) * 64 + 32 + r32) * 16);
        pa0 = __builtin_amdgcn_mfma_f32_32x32x16_bf16(k0, qr[d], pa0, 0, 0, 0); pa1 = __builtin_amdgcn_mfma_f32_32x32x16_bf16(k1, qr[d], pa1, 0, 0, 0);
    }
    f32x16 negm;
    { float mx = fmaxf(pa0[0], pa1[0]);
#pragma unroll
      for (int r = 1; r < 16; ++r) mx = fmaxf(mx, fmaxf(pa0[r], pa1[r]));
      mx = fmaxf(mx, __shfl_xor(mx, 32)); mrun = mx;
#pragma unroll
      for (int r = 0; r < 16; ++r) { pa0[r] -= mx; pa1[r] -= mx; negm[r] = -mx; } }
    bool track;
    { const float* qnw = F.in[19]; const float* knw = F.in[20]; float gq = 0.f, gk = 0.f;
      for (int i = 0; i < QKD; ++i) { gq = fmaxf(gq, fabsf(qnw[i])); gk = fmaxf(gk, fabsf(knw[i])); }
      track = !(gq * gk < ATT_TRACK_LIMIT); }
    int t = 0;
    for (; t + 2 < NT; t += 2) {
        attn_step<false>(pa0, pa1, pb0, pb1, o0, o1, mrun, lsum, negm, track, qr, lds, t, NT, KV, tid, r32, hi, voff);
        attn_step<false>(pb0, pb1, pa0, pa1, o0, o1, mrun, lsum, negm, track, qr, lds, t + 1, NT, KV, tid, r32, hi, voff);
    }
    attn_step<false>(pa0, pa1, pb0, pb1, o0, o1, mrun, lsum, negm, track, qr, lds, t, NT, KV, tid, r32, hi, voff);
    attn_step<true>(pb0, pb1, pa0, pa1, o0, o1, mrun, lsum, negm, track, qr, lds, t + 1, NT, KV, tid, r32, hi, voff);
    lsum += __shfl_xor(lsum, 32);
    const float il = 1.0f / lsum;
    const int b = bh >> 3, h = bh & 7;
    const size_t mrow = (prompt ? 0 : (size_t)MP) + (size_t)b * L + qb * 256 + wid * 32 + r32;
    float* yo = (float*)(F.ws + WS_YMLA) + mrow * 512 + h * 64 + 4 * hi;
#pragma unroll
    for (int g = 0; g < 4; ++g) { *(f32x4*)(yo + 8 * g) = (f32x4){o0[4 * g] * il, o0[4 * g + 1] * il, o0[4 * g + 2] * il, o0[4 * g + 3] * il};
        *(f32x4*)(yo + 32 + 8 * g) = (f32x4){o1[4 * g] * il, o1[4 * g + 1] * il, o1[4 * g + 2] * il, o1[4 * g + 3] * il}; }
}

__device__ __forceinline__ float2 cmul(float2 a, float2 b) { return make_float2(ffms_s(a.x, b.x, fmul_s(a.y, b.y)), ffma_s(a.x, b.y, fmul_s(a.y, b.x))); }
__device__ __forceinline__ float2 cmulc(float2 a, float2 b) { return make_float2(ffma_s(a.x, b.x, fmul_s(a.y, b.y)), ffms_s(a.y, b.x, fmul_s(a.x, b.y))); }
__device__ __forceinline__ float2 cadd(float2 a, float2 b) { return make_float2(fadd_s(a.x, b.x), fadd_s(a.y, b.y)); }
__device__ __forceinline__ float2 csub(float2 a, float2 b) { return make_float2(fsub_s(a.x, b.x), fsub_s(a.y, b.y)); }
template <bool INV> __device__ __forceinline__ void bfly4(float2& x0, float2& x1, float2& x2, float2& x3, float rev, float one, float mone) {
    const float2 w1 = make_float2(__builtin_amdgcn_cosf(rev) * one, __builtin_amdgcn_sinf(rev) * mone); const float2 w2 = cmul(w1, w1), w3 = cmul(w2, w1);
    if (!INV) {
        const float2 a = cadd(x0, x2), bq = csub(x0, x2), c = cadd(x1, x3), d = csub(x1, x3);
        const float2 y1 = make_float2(fadd_s(bq.x, d.y), fsub_s(bq.y, d.x)), y3 = make_float2(fsub_s(bq.x, d.y), fadd_s(bq.y, d.x));
        x0 = cadd(a, c); x2 = cmul(csub(a, c), w2); x1 = cmul(y1, w1); x3 = cmul(y3, w3);
    } else {
        x1 = cmulc(x1, w1); x2 = cmulc(x2, w2); x3 = cmulc(x3, w3);
        const float2 a = cadd(x0, x2), bq = csub(x0, x2), c = cadd(x1, x3), d = csub(x1, x3);
        x0 = cadd(a, c); x2 = csub(a, c); x1 = make_float2(fsub_s(bq.x, d.y), fadd_s(bq.y, d.x)); x3 = make_float2(fadd_s(bq.x, d.y), fsub_s(bq.y, d.x));
    }
}
#define PHI(i) ((i) + ((i) >> 4))
#define PADN(n) ((n) + ((n) >> 4))
template <bool INV> __device__ __forceinline__ void fft_lds(float2* buf0, int N, int logN, const float2* tw, int tid, int nbuf = 1) {
    (void)tw;
    float one = 1.0f, mone = -1.0f; asm volatile("" : "+v"(one), "+v"(mone));
    const int nst = logN >> 1, npair = nst >> 1, odd = nst & 1;
    const int npass = npair + odd;
    for (int ps = 0; ps < npass; ++ps) {
        const int pi = INV ? (npass - 1 - ps) : ps;
        if (pi < npair) {
            const int lsA = logN - 2 - 4 * pi, lsB = lsA - 2;
            const int s = 1 << lsA, sp = 1 << lsB;
            const float rA = 1.0f / (float)(4 * s), rB = 1.0f / (float)s;
#pragma unroll 2
            for (int gg = tid; gg < nbuf * (N >> 4); gg += NTHR) {
                const int g = gg & ((N >> 4) - 1); float2* buf = buf0 + (size_t)(gg >> (logN - 4)) * PADN(N);
                const int n0 = g & (sp - 1), base = ((g >> lsB) << (lsA + 2)) + n0;
                float2 x[4][4];
#pragma unroll
                for (int a = 0; a < 4; ++a)
#pragma unroll
                    for (int b = 0; b < 4; ++b) x[a][b] = buf[PHI(base + a * sp + b * s)];
                if (!INV) {
#pragma unroll
                    for (int a = 0; a < 4; ++a) bfly4<false>(x[a][0], x[a][1], x[a][2], x[a][3], (float)(n0 + a * sp) * rA, one, mone);
#pragma unroll
                    for (int q = 0; q < 4; ++q) bfly4<false>(x[0][q], x[1][q], x[2][q], x[3][q], (float)n0 * rB, one, mone);
                } else {
#pragma unroll
                    for (int q = 0; q < 4; ++q) bfly4<true>(x[0][q], x[1][q], x[2][q], x[3][q], (float)n0 * rB, one, mone);
#pragma unroll
                    for (int a = 0; a < 4; ++a) bfly4<true>(x[a][0], x[a][1], x[a][2], x[a][3], (float)(n0 + a * sp) * rA, one, mone);
                }
#pragma unroll
                for (int a = 0; a < 4; ++a)
#pragma unroll
                    for (int b = 0; b < 4; ++b) buf[PHI(base + a * sp + b * s)] = x[a][b];
            }
        } else {
#pragma unroll 4
            for (int g = tid; g < nbuf * (N >> 2); g += NTHR) {
                float2* buf = buf0;
                const int base = g << 2;
                const int pb = PHI(base);
                float2 x0 = buf[pb], x1 = buf[pb + 1], x2 = buf[pb + 2], x3 = buf[pb + 3];
                bfly4<INV>(x0, x1, x2, x3, 0.0f, one, mone);
                buf[pb] = x0; buf[pb + 1] = x1; buf[pb + 2] = x2; buf[pb + 3] = x3;
            }
        }
        __syncthreads();
    }
}
template <bool prompt> __device__ __forceinline__ void fft_unit(Frame& F, int c) {
    const int tid = ((int)threadIdx.x); constexpr int L = prompt ? LP : LS, N = 2 * L, logN = prompt ? 14 : 12, nb = prompt ? BP : BS;
    float2* buf = (float2*)F.lds; float* w3l = (float*)(F.lds + LDSX_OFF);
    const float2* tw = (const float2*)(F.ws + WS_TW);
    float2* kspec = (float2*)(F.ws + WS_KSPEC) + (size_t)blockIdx.x * 16384;
    const float* h2 = (const float*)(F.ws + (prompt ? WS_H2P : WS_H2S));
    const bf16* zbase = (const bf16*)F.out + (prompt ? 0 : (size_t)MP * HYW); bf16* xbase = (bf16*)(F.out + (size_t)MT * HYW) + (prompt ? 0 : (size_t)MP * HYW);
    const float* w3 = F.in[13];
#ifndef FFT_REP
#define FFT_REP 1
#endif
#pragma unroll 1
    for (int rep = 0; rep < FFT_REP; ++rep) {
    const float bias = F.in[14][c];
    { const float* kf_ = (const float*)(F.ws + (prompt ? WS_KERNP : WS_KERNS)) + (size_t)c * L; const float* kb_ = kf_ + (size_t)512 * L;
#pragma unroll
      for (int i = 0; i < L / NTHR; ++i) { const int j = tid + i * NTHR; buf[PHI(j)] = make_float2(kf_[j] + (j == 0 ? bias : 0.f), 0.f); buf[PHI(N - 1 - j)] = make_float2(kb_[j], 0.f); } }
    __syncthreads();
    fft_lds<false>(buf, N, logN, tw, tid);
#pragma unroll 8
    for (int i = 0; i < N / NTHR; ++i) { const int p = tid + i * NTHR; kspec[p] = buf[PHI(p)]; }
    __syncthreads();
    const float invN = 1.0f / (float)N;
    constexpr int NBUF = prompt ? 1 : 4;
    for (int rd = 0; rd < (nb / 2) / NBUF; ++rd) {
#pragma unroll
        for (int k = 0; k < NBUF; ++k) { const int pr = rd * NBUF + k; float2* bk = buf + (size_t)k * PADN(N);
            const bf16* za = zbase + ((size_t)((2 * pr) * HYW + c) * L); const bf16* zb = zbase + ((size_t)((2 * pr + 1) * HYW + c) * L);
#pragma unroll
            for (int i = 0; i < L / NTHR; ++i) { const int t = tid + i * NTHR; bk[PHI(t)] = make_float2(bf2f(za[t]), bf2f(zb[t])); bk[PHI(L + t)] = make_float2(0.f, 0.f); } }
        __syncthreads();
        fft_lds<false>(buf, N, logN, tw, tid, NBUF);
#pragma unroll
        for (int k = 0; k < NBUF; ++k) { float2* bk = buf + (size_t)k * PADN(N);
#pragma unroll 8
            for (int i = 0; i < N / NTHR; ++i) { const int p = tid + i * NTHR; bk[PHI(p)] = cmul(bk[PHI(p)], kspec[p]); } }
        __syncthreads();
        fft_lds<true>(buf, N, logN, tw, tid, NBUF);
        if (rep == FFT_REP - 1) {
#pragma unroll
        for (int k = 0; k < NBUF; ++k) { const int pr = rd * NBUF + k; const float2* bk = buf + (size_t)k * PADN(N);
            bf16* xa = xbase + ((size_t)((2 * pr) * HYW + c) * L); bf16* xb = xbase + ((size_t)((2 * pr + 1) * HYW + c) * L);
#pragma unroll
            for (int i = 0; i < (L / NTHR < 8 ? L / NTHR : 8); ++i) { const int t = tid + i * NTHR; const float2 v = bk[PHI(t)];
                xa[t] = (bf16)f2bf(bf2f(xa[t]) * (v.x * invN)); xb[t] = (bf16)f2bf(bf2f(xb[t]) * (v.y * invN)); }
            if (L / NTHR > 8) {
#pragma unroll
            for (int i = 8; i < L / NTHR; ++i) { const int t = tid + i * NTHR; const float2 v = bk[PHI(t)];
                xa[t] = (bf16)f2bf(bf2f(xa[t]) * (v.x * invN)); xb[t] = (bf16)f2bf(bf2f(xb[t]) * (v.y * invN)); } } }
        }
        __syncthreads();
    }
    }
}
#undef PHI
#undef PADN

__device__ __forceinline__ void p4_unit(Frame& F, int unit) {
    const int tid = ((int)threadIdx.x), lane = ((int)threadIdx.x & 63), wid = F.wave; const int m0 = unit * 32;
    float* tile = (float*)F.lds;
    int b, t0, L; const bf16* yb = (const bf16*)(F.out + (size_t)MT * HYW);
    if (m0 < MP) { b = m0 / LP; t0 = m0 % LP; L = LP; } else { const int mm = m0 - MP; b = mm / LS; t0 = mm % LS; L = LS; yb += (size_t)MP * HYW; }
    { const u32x4* src = (const u32x4*)(yb + ((size_t)(b * HYW + tid) * L + t0));
#pragma unroll
      for (int i = 0; i < 4; ++i) { const u32x4 v = src[i]; const unsigned w[4] = {v.x, v.y, v.z, v.w};
#pragma unroll
          for (int e = 0; e < 4; ++e) { tile[(8 * i + 2 * e) * 512 + tid] = __uint_as_float(w[e] << 16); tile[(8 * i + 2 * e + 1) * 512 + tid] = __uint_as_float(w[e] & 0xffff0000u); } } }
    __syncthreads();
    bf16* mix = (bf16*)(F.ws + WS_MIX); const float* hw = F.in[21]; const float* mw = F.in[22]; const float* ym = (const float*)(F.ws + WS_YMLA);
#pragma unroll
    for (int i = 0; i < 4; ++i) { const int tk = wid * 4 + i; const size_t m = (size_t)m0 + tk;
        { const f32x4 a = *(const f32x4*)(tile + tk * 512 + lane * 8), c = *(const f32x4*)(tile + tk * 512 + lane * 8 + 4);
          float ss = (a.x * a.x + a.y * a.y) + (a.z * a.z + a.w * a.w) + (c.x * c.x + c.y * c.y) + (c.z * c.z + c.w * c.w); ss = wave_sum(ss);
          const float r = 1.0f / sqrtf(ss * (1.0f / 512.0f) + EPS); const f32x4 wa = *(const f32x4*)(hw + lane * 8), wc = *(const f32x4*)(hw + lane * 8 + 4);
          u32x4 w; w.x = pk2(a.x * r * wa.x, a.y * r * wa.y); w.y = pk2(a.z * r * wa.z, a.w * r * wa.w); w.z = pk2(c.x * r * wc.x, c.y * r * wc.y); w.w = pk2(c.z * r * wc.z, c.w * r * wc.w);
          *(u32x4*)(mix + m * 1024 + lane * 8) = w; }
        { const f32x4 a = *(const f32x4*)(ym + m * 512 + lane * 8), c = *(const f32x4*)(ym + m * 512 + lane * 8 + 4);
          float ss = (a.x * a.x + a.y * a.y) + (a.z * a.z + a.w * a.w) + (c.x * c.x + c.y * c.y) + (c.z * c.z + c.w * c.w); ss = wave_sum(ss);
          const float r = 1.0f / sqrtf(ss * (1.0f / 512.0f) + EPS); const f32x4 wa = *(const f32x4*)(mw + lane * 8), wc = *(const f32x4*)(mw + lane * 8 + 4);
          u32x4 w; w.x = pk2(a.x * r * wa.x, a.y * r * wa.y); w.y = pk2(a.z * r * wa.z, a.w * r * wa.w); w.z = pk2(c.x * r * wc.x, c.y * r * wc.y); w.w = pk2(c.z * r * wc.z, c.w * r * wc.w);
          *(u32x4*)(mix + m * 1024 + 512 + lane * 8) = w; } }
    __syncthreads();
}
#define XB_TMO      128
#define XB_XCNT(j)  (256  + 64 * (j))
#define XB_XSUB(j)  (1280 + 64 * (j))
#define XB_XGEN(j)  (2304 + 64 * (j))
#define XB_TOP      3328
#define XB_TOPGEN   3392
#define XCD_BAR_WORDS 3456
#define XB_SPIN_CAP (1u << 18)

__device__ __forceinline__ unsigned xb_ld(unsigned* p)              { return __hip_atomic_load(p, __ATOMIC_RELAXED, __HIP_MEMORY_SCOPE_AGENT); }
__device__ __forceinline__ unsigned xb_add(unsigned* p, unsigned v) { return __hip_atomic_fetch_add(p, v, __ATOMIC_RELAXED, __HIP_MEMORY_SCOPE_AGENT); }
__device__ __forceinline__ unsigned xb_xcc_id() { return (unsigned)__builtin_amdgcn_s_getreg((3 << 11) | 20) & 0xFu; }
#define XB_SPIN(cond, bar) do { unsigned _sp = 0; while (cond) { __builtin_amdgcn_s_sleep(1); \
    if ((++_sp & 255u) == 0u) { if (xb_ld(&(bar)[XB_TMO])) break; if (_sp > XB_SPIN_CAP) { atomicAdd(&(bar)[XB_TMO], 1u); break; } } } } while (0)

struct XcdBarrier {
    unsigned* bar; unsigned x;
    volatile LAS unsigned* st;
};

__device__ __forceinline__ XcdBarrier xcd_barrier_post(unsigned* bar, volatile LAS unsigned* st) {
    XcdBarrier b; b.bar = bar; b.x = xb_xcc_id(); b.st = st;
    if (threadIdx.x == 0) (void)xb_add(&bar[XB_XCNT(b.x)], 1u);
    return b;
}
__device__ __forceinline__ void xcd_barrier_complete(unsigned* bar, unsigned x, unsigned& nloc, unsigned& nx) {
    const unsigned G = gridDim.x * gridDim.y * gridDim.z;
    unsigned sum, cnt, mine, sp = 0u;
    for (;;) {
        sum = 0u; cnt = 0u; mine = 0u;
#pragma unroll
        for (unsigned j = 0; j < 16; ++j) { const unsigned c = xb_ld(&bar[XB_XCNT(j)]); sum += c; cnt += (c > 0u) ? 1u : 0u; mine = (j == x) ? c : mine; }
        if (sum == G) break;
        __builtin_amdgcn_s_sleep(1);
        if ((++sp & 255u) == 0u) { if (xb_ld(&bar[XB_TMO])) break; if (sp > XB_SPIN_CAP) { atomicAdd(&bar[XB_TMO], 1u); break; } }
    }
    nloc = mine > 0u ? mine : 1u; nx = cnt > 0u ? cnt : 1u;
}

__device__ __forceinline__ void xcd_barrier(const XcdBarrier& b) {
    asm volatile("s_waitcnt vmcnt(0)" ::: "memory");
    __syncthreads();
    if (threadIdx.x == 0) {
        unsigned* bar = b.bar;
        __builtin_amdgcn_s_waitcnt(0);
        unsigned nloc = b.st[0], nx = b.st[1];
        if (nloc == 0u) { xcd_barrier_complete(bar, b.x, nloc, nx); b.st[0] = nloc; b.st[1] = nx; }
        const unsigned old = xb_add(&bar[XB_XSUB(b.x)], 1u);
        const unsigned gen = old / nloc;
        if (old + 1u == (gen + 1u) * nloc) {
            __builtin_amdgcn_fence(__ATOMIC_RELEASE, "agent");
            asm volatile("s_waitcnt vmcnt(0)" ::: "memory");
            const unsigned og = xb_add(&bar[XB_TOP], 1u);
            const unsigned tg = og / nx;
            if (og + 1u == (tg + 1u) * nx) xb_add(&bar[XB_TOPGEN], 1u);
            else XB_SPIN(xb_ld(&bar[XB_TOPGEN]) == tg, bar);
            __builtin_amdgcn_fence(__ATOMIC_ACQUIRE, "agent");
            xb_add(&bar[XB_XGEN(b.x)], 1u);
            asm volatile("s_waitcnt vmcnt(0)" ::: "memory");
        } else {
            XB_SPIN(xb_ld(&bar[XB_XGEN(b.x)]) == gen, bar);
            __builtin_amdgcn_fence(__ATOMIC_ACQUIRE, "agent");
            asm volatile("s_waitcnt vmcnt(0)" ::: "memory");
        }
    }
    __syncthreads();
}
constexpr int N_PHASES = 12;
#ifndef SKIPMASK
#define SKIPMASK 0
#endif
__global__ void __launch_bounds__(NTHR, 2) mk_fwd(Args args) {
    extern __shared__ __attribute__((aligned(16))) unsigned char lds[];
    Frame F;
    F.lds = lds; F.wave = __builtin_amdgcn_readfirstlane((int)threadIdx.x >> 6);
    F.G = gridDim.x; { const int bx = blockIdx.x; F.vcu = (F.G % 8 == 0) ? (bx % 8) * (F.G / 8) + bx / 8 : bx; }
#pragma unroll
    for (int i = 0; i < 30; ++i) F.in[i] = args.in[i];
    F.out = args.out; F.ws = args.ws;
    unsigned char* ws = args.ws;
    LAS unsigned char* ldsl = (LAS unsigned char*)lds;
    for (int u = (int)threadIdx.x; u < (LDS_BYTES - LDSCTL_OFF) / 4; u += NTHR) ((LAS unsigned*)(ldsl + LDSCTL_OFF))[u] = 0u;
    __syncthreads();
    const int lo = args.ph_lo, hi = args.ph_hi;
    XcdBarrier bar; bar.bar = (unsigned*)(ws + WS_CTL) + CW_BAR; bar.x = 0; bar.st = nullptr;
#if MK_COOP && MK_XCDBAR
    bar = xcd_barrier_post((unsigned*)(ws + WS_CTL) + CW_BAR, (volatile LAS unsigned*)(ldsl + MISC_OFF) + 8);
#endif
#define IN(k) (lo <= (k) && (k) < hi)
#define BOTH(k) (IN(k) && IN((k) + 1))
#if MK_COOP
#if MK_XCDBAR
#ifndef BAR_REP
#define BAR_REP 1
#endif
#define GRID_BAR(k) do { if ((k) == 0) cg::this_grid().sync(); else { for (int br_ = 0; br_ < BAR_REP; ++br_) xcd_barrier(bar); } } while (0)
#else
#define GRID_BAR(k) cg::this_grid().sync()
#endif
#else
#define GRID_BAR(k) do { } while (0)
#endif
    bf16* xb = (bf16*)(ws + WS_A);
    float* rowss1 = (float*)(ws + WS_ROWSS1); float* rowssp = (float*)(ws + WS_ROWSSP);
    bf16* hmid = (bf16*)(ws + WS_HMID);

#ifndef P0_REP
#define P0_REP 1
#endif
    if (IN(0) && !(SKIPMASK >> 0 & 1)) {
#pragma unroll 1
        for (int rep = 0; rep < P0_REP; ++rep) p0_prologue(F); if (BOTH(0)) GRID_BAR(0); }
    if (IN(1) && !(SKIPMASK >> 1 & 1)) {
        pg8::Gemm g{xb, (const bf16*)(ws + WS_WIN), MT, NIN, 1024}; pg8::StaticOrder S; S.init(MT, NIN, F.G, (int)blockIdx.x);
        pg8::EpiScaleBf16 E{(bf16*)(ws + WS_B), NIN, (const float*)(ws + WS_RSTD0)};
#ifndef P1_REP
#define P1_REP 1
#endif
#pragma unroll 1
        for (int rep = 0; rep < P1_REP; ++rep) pg8::gemm_phase<pg8::EpiScaleBf16, pg8::StaticOrder, true, true>(ldsl, g, S, E);
        if (BOTH(1)) GRID_BAR(1);
    }
    if (IN(2) && !(SKIPMASK >> 2 & 1)) {
#ifndef P2A_REP
#define P2A_REP 1
#endif
#ifndef P2B_REP
#define P2B_REP 1
#endif
#pragma unroll 1
        for (int rep = 0; rep < P2A_REP; ++rep) for (int t = F.vcu; t < MT / 192; t += F.G) p2_mla_wg(F, t);
#pragma unroll 1
        for (int rep = 0; rep < P2B_REP; ++rep) for (int u = F.vcu; u < MT / 32; u += F.G) p2_hyena_front(F, u);
        for (int u = F.vcu; u < 640; u += F.G) p2_filter_item(F, u);
        if (BOTH(2)) GRID_BAR(2);
    }
    if (IN(3) && !(SKIPMASK >> 3 & 1)) {
#ifndef ATTN_REP
#define ATTN_REP 1
#endif
#ifndef FFT_REP
#define FFT_REP 1
#endif
#pragma unroll 1
        for (int rep = 0; rep < ATTN_REP; ++rep) {
        for (int u = F.vcu; u < 1024; u += F.G) attn_unit(F, true, u >> 5, u & 31);
        for (int u = F.vcu; u < 512; u += F.G) attn_unit(F, false, u >> 3, u & 7);
        }
        for (int c = F.vcu; c < HYW; c += F.G) fft_unit<true>(F, c);
        for (int c = F.vcu; c < HYW; c += F.G) fft_unit<false>(F, c);
        if (BOTH(3)) GRID_BAR(3);
    }
    if (IN(4) && !(SKIPMASK >> 4 & 1)) {
#ifndef P4_REP
#define P4_REP 1
#endif
#pragma unroll 1
        for (int rep = 0; rep < P4_REP; ++rep) for (int u = F.vcu; u < MT / 32; u += F.G) p4_unit(F, u);
        if (BOTH(4)) GRID_BAR(4);
    }
    if (IN(5) && !(SKIPMASK >> 5 & 1)) {
        pg8::Gemm g{(const bf16*)(ws + WS_MIX), (const bf16*)(ws + WS_WOUT), MT, 1024, 1024}; pg8::StaticOrder S; S.init(MT, 1024, F.G, (int)blockIdx.x);
        pg8::EpiResBf16 E{args.in[0], args.in[1], MP, nullptr, xb, rowss1, 0};
        pg8::gemm_phase<pg8::EpiResBf16, pg8::StaticOrder, true, true>(ldsl, g, S, E);
        if (BOTH(5)) GRID_BAR(5);
    }
    if (IN(6) && !(SKIPMASK >> 6 & 1)) {
        pg8::Gemm g{xb, (const bf16*)(ws + WS_W1), MP, DFF, 1024}; pg8::StaticOrder S; S.init(MP, DFF, F.G, (int)blockIdx.x);
        pg8::EpiRelu2Bf16 E{hmid, DFF, rowss1, 0};
#ifndef P6_REP
#define P6_REP 1
#endif
#pragma unroll 1
        for (int rep = 0; rep < P6_REP; ++rep) pg8::gemm_phase<pg8::EpiRelu2Bf16, pg8::StaticOrder, true, true>(ldsl, g, S, E);
        if (BOTH(6)) GRID_BAR(6);
    }
    if (IN(7) && !(SKIPMASK >> 7 & 1)) {
        pg8::Gemm g{hmid, (const bf16*)(ws + WS_W2), MP, 1024, DFF}; pg8::StaticOrder S; S.init(MP, 1024, F.G, (int)blockIdx.x);
        pg8::EpiResBf16 E{nullptr, nullptr, 0, xb, xb, nullptr, 0};
        pg8::gemm_phase<pg8::EpiResBf16, pg8::StaticOrder, true, true>(ldsl, g, S, E);
        if (BOTH(7)) GRID_BAR(7);
    }
    if (IN(8) && !(SKIPMASK >> 8 & 1)) {
        pg8::Gemm g{xb + (size_t)MP * 1024, (const bf16*)(ws + WS_W1), MS, DFF, 1024}; pg8::StaticOrder S; S.init(MS, DFF, F.G, (int)blockIdx.x);
        pg8::EpiRelu2Bf16 E{hmid, DFF, rowss1, MP};
        pg8::gemm_phase<pg8::EpiRelu2Bf16, pg8::StaticOrder, true, true>(ldsl, g, S, E);
        if (BOTH(8)) GRID_BAR(8);
    }
    if (IN(9) && !(SKIPMASK >> 9 & 1)) {
        pg8::Gemm g{hmid, (const bf16*)(ws + WS_W2), MS, 1024, DFF}; pg8::StaticOrder S; S.init(MS, 1024, F.G, (int)blockIdx.x);
        pg8::EpiResBf16 E{nullptr, nullptr, 0, xb, xb, nullptr, MP};
        pg8::gemm_phase<pg8::EpiResBf16, pg8::StaticOrder, true, true>(ldsl, g, S, E);
        if (BOTH(9)) GRID_BAR(9);
    }
    if (IN(10) && !(SKIPMASK >> 10 & 1)) {
        pg8::Gemm g{(const bf16*)(ws + WS_PB), (const bf16*)(ws + WS_WPP), MT, 1024, PLE}; pg8::StaticOrder S; S.init(MT, 1024, F.G, (int)blockIdx.x);
        pg8::EpiBf16Ss E{(bf16*)(ws + WS_PP), 1024, rowssp};
        pg8::gemm_phase<pg8::EpiBf16Ss, pg8::StaticOrder, true, true>(ldsl, g, S, E);
        if (BOTH(10)) GRID_BAR(10);
    }
    if (IN(11) && !(SKIPMASK >> 11 & 1)) {
        pg8::Gemm g{xb, (const bf16*)(ws + WS_WG), MT, 1024, 1024}; pg8::StaticOrder S; S.init(MT, 1024, F.G, (int)blockIdx.x);
        pg8::EpiFinal E{args.out, xb, (const bf16*)(ws + WS_PP), rowssp, args.in[29]};
        pg8::gemm_phase<pg8::EpiFinal, pg8::StaticOrder, true, true>(ldsl, g, S, E);
    }
#undef IN
#undef BOTH
}

extern "C" void kernel_launch(void* const* d_in, const int* in_sizes, int n_in, void* d_out, int out_size, void* d_ws, size_t ws_size, hipStream_t stream) {
    static int grid = 0;
    if (grid == 0) {
        if (n_in != 30 || out_size != MT * DM || ws_size < WS_END) { fprintf(stderr, "kernel_launch: unexpected shapes (n_in %d out %d ws %zu)\n", n_in, out_size, ws_size); grid = -1; return; }
        int dev = 0, cus = 0, per_cu = 0;
        if (hipGetDevice(&dev) != hipSuccess || hipDeviceGetAttribute(&cus, hipDeviceAttributeMultiprocessorCount, dev) != hipSuccess) { grid = -1; return; }
        if (hipFuncSetAttribute((const void*)mk_fwd, hipFuncAttributeMaxDynamicSharedMemorySize, LDS_BYTES) != hipSuccess) { fprintf(stderr, "kernel_launch: hipFuncSetAttribute failed\n"); grid = -1; return; }
        if (hipOccupancyMaxActiveBlocksPerMultiprocessor(&per_cu, (const void*)mk_fwd, NTHR, LDS_BYTES) != hipSuccess || per_cu < 1) fprintf(stderr, "kernel_launch: occupancy query says %d\n", per_cu);
        (void)hipGetLastError();
        grid = cus;
    }
    if (grid < 0) return;
    (void)hipMemsetAsync((char*)d_ws + WS_CTL, 0, CTL_ZERO_BYTES, stream);
    Args a{};
    for (int i = 0; i < 30; ++i) a.in[i] = (const float*)d_in[i];
    a.out = (float*)d_out; a.ws = (unsigned char*)d_ws;
#if MK_COOP
    a.ph_lo = 0; a.ph_hi = N_PHASES;
    void* kargs[] = {&a};
    hipError_t e = hipLaunchCooperativeKernel((const void*)mk_fwd, dim3(grid), dim3(NTHR), kargs, LDS_BYTES, stream);
    if (e != hipSuccess) fprintf(stderr, "kernel_launch: cooperative launch failed: %s (grid %d)\n", hipGetErrorString(e), grid);
#else
    for (int p = 0; p < N_PHASES; ++p) { a.ph_lo = p; a.ph_hi = p + 1; hipLaunchKernelGGL(mk_fwd, dim3(grid), dim3(NTHR), LDS_BYTES, stream, a); }
#endif
}
```

```cpp
#include <hip/hip_runtime.h>
#include <hip/hip_cooperative_groups.h>
#include <cstdio>
#include <cstdint>
namespace cg = cooperative_groups;
#define ATTN_REP 1
#define ATT_SCHED 0
#ifndef MK_COOP
#define MK_COOP 1
#endif
#ifndef MK_XCDBAR
#define MK_XCDBAR 1
#endif
namespace pg8 {
#define PG8_LAS __attribute__((address_space(3)))
typedef unsigned short bf16_t;
typedef short bf16x8 __attribute__((ext_vector_type(8)));
typedef float f32x4 __attribute__((ext_vector_type(4)));
typedef unsigned u32x4 __attribute__((ext_vector_type(4)));
constexpr int BM = 256, BK = 64, HALF = 128, HTB = HALF * BK * 2  , STAGE_BYTES = 8 * HTB, NXCD = 8, WGM = 8;

__host__ __device__ __forceinline__ int lds_byte(int r, int c) { const int st = (r >> 4) * 2 + (c >> 5), rr = r & 15, cc = c & 31, ob = rr * 64 + cc * 2; return st * 1024 + (ob ^ (((ob >> 9) & 1) << 5)); }
__host__ __device__ __forceinline__ void stage_rc(int b, int& R, int& C) { const int st = b / 1024, sb = b % 1024, swz = sb ^ (((sb >> 9) & 1) << 5); R = (st >> 1) * 16 + swz / 64; C = (st & 1) * 32 + (swz % 64) / 2; }
__host__ __device__ __forceinline__ int perm32(int rho) { const int n = rho >> 4, i = rho & 15; return 8 * (i >> 2) + 4 * n + (i & 3); }

struct Unit { int pm, pn; };
struct Gemm { const bf16_t* A; const bf16_t* Bt; int M, N, K; };

struct StaticOrder {
    int nM, nN, nwg, G, c;
    __host__ __device__ void init(int M, int N, int G_, int c_) { nM = M / BM; nN = N / BM; nwg = nM * nN; G = G_; c = c_; }
    __host__ __device__ bool next(int i, Unit& u) const {
        const long L = (long)i * G + c; if (L >= nwg) return false;
        int wgid = (int)L; { const int q = nwg / NXCD, r = nwg % NXCD, xcd = wgid % NXCD, off = wgid / NXCD; wgid = (xcd < r ? xcd * (q + 1) : r * (q + 1) + (xcd - r) * q) + off; }
        const int nig = WGM * nN, gid = wgid / nig, fm = gid * WGM, gsz = (nM - fm) < WGM ? (nM - fm) : WGM;
        u.pm = fm + ((wgid % nig) % gsz); u.pn = (wgid % nig) / gsz; return true;
    }
    __device__ __forceinline__ void a_ready(const Unit&) const {}
    __device__ __forceinline__ void done(const Unit&) const {}
};

__device__ __forceinline__ unsigned cvt_pk_bf16(float lo, float hi) { unsigned r; asm volatile("v_cvt_pk_bf16_f32 %0, %1, %2" : "=v"(r) : "v"(lo), "v"(hi)); return r; }
typedef float f32x2 __attribute__((ext_vector_type(2)));
template <class Epi, class Sched, bool ALIGN_EPI = false, bool SP2 = false>
__device__ __forceinline__ void gemm_phase(PG8_LAS unsigned char* lds, const Gemm g, const Sched& S, const Epi& E) {
    const int tid = threadIdx.x, wid = __builtin_amdgcn_readfirstlane(tid >> 6), lane = tid & 63, wr = wid >> 2, wc = wid & 3, fr = lane & 15, fq = lane >> 4;
    const int K = g.K, nt = K / BK;
    unsigned voffA[2], voffB[2];
#pragma unroll
    for (int i = 0; i < 2; ++i) { int R, C; stage_rc(tid * 16 + i * 8192, R, C); const int Rb = Epi::PERM ? ((R & ~31) + perm32(R & 31)) : R;
        voffA[i] = (unsigned)(R * K + C) * 2u; voffB[i] = (unsigned)(Rb * K + C) * 2u; }
    const size_t kstep = (size_t)(BK * 2);
    const size_t hstep = (size_t)HALF * K * 2;
    const size_t tstep = 2 * hstep;
    const unsigned ldsw = (unsigned)wid * 1024u;
    const int aoff = lds_byte(wr * 64 + fr, fq * 8), boff = lds_byte(wc * 32 + fr, fq * 8);
#define PG8_SA(b, h) (((b) * 2 + (h)) * HTB)
#define PG8_SB(b, h) ((4 + (b) * 2 + (h)) * HTB)
#define PG8_STAGE(bufoff, gbase, voff) do { _Pragma("unroll") for (int _i = 0; _i < 2; ++_i) \
        __builtin_amdgcn_global_load_lds((const unsigned*)((const char*)(gbase) + (voff)[_i]), (PG8_LAS unsigned*)(lds + (bufoff) + ldsw + _i * 8192), 16, 0, 0); } while (0)
#define PG8_LDA(dst, b, h) do { _Pragma("unroll") for (int m = 0; m < 4; ++m) _Pragma("unroll") for (int k = 0; k < 2; ++k) dst[m][k] = *(const PG8_LAS bf16x8*)(lds + PG8_SA(b, h) + aoff + m * 2048 + k * 1024); } while (0)
#define PG8_LDB(dst, b, h) do { _Pragma("unroll") for (int n = 0; n < 2; ++n) _Pragma("unroll") for (int k = 0; k < 2; ++k) dst[n][k] = *(const PG8_LAS bf16x8*)(lds + PG8_SB(b, h) + boff + n * 2048 + k * 1024); } while (0)
#define PG8_MMA(ai, bj, At, Bt) do { __builtin_amdgcn_s_setprio(1); _Pragma("unroll") for (int m = 0; m < 4; ++m) _Pragma("unroll") for (int n = 0; n < 2; ++n) _Pragma("unroll") for (int k = 0; k < 2; ++k) \
        acc[ai][bj][m][n] = __builtin_amdgcn_mfma_f32_16x16x32_bf16(Bt[n][k], At[m][k], acc[ai][bj][m][n], 0, 0, 0); __builtin_amdgcn_s_setprio(0); } while (0)
#define PG8_WAIT_V(n) asm volatile("s_waitcnt vmcnt(" #n ")" ::: "memory")
#define PG8_WAIT_L(n) asm volatile("s_waitcnt lgkmcnt(" #n ")" ::: "memory")
#define PG8_BAR __builtin_amdgcn_s_barrier()
#define PG8_SCHED __builtin_amdgcn_sched_barrier(0)
    Unit cur, nxt; int ui = 0;
    if (!S.next(0, cur)) return;
    f32x4 acc[2][2][4][2];
#pragma unroll
    for (int a = 0; a < 2; ++a)
#pragma unroll
        for (int b = 0; b < 2; ++b)
#pragma unroll
            for (int m = 0; m < 4; ++m)
#pragma unroll
                for (int n = 0; n < 2; ++n) acc[a][b][m][n] = (f32x4){0.f, 0.f, 0.f, 0.f};
    bf16x8 At[4][2], B0[2][2], B1[2][2];
    const char* cA = (const char*)g.A + (size_t)cur.pm * tstep; const char* cB = (const char*)g.Bt + (size_t)cur.pn * tstep;
    S.a_ready(cur);
    if constexpr (SP2) {
        PG8_STAGE(PG8_SB(0, 0), cB, voffB); PG8_STAGE(PG8_SB(0, 1), cB + hstep, voffB); PG8_STAGE(PG8_SA(0, 0), cA, voffA); PG8_STAGE(PG8_SA(0, 1), cA + hstep, voffA);
        if (wr == 1) PG8_BAR;
        PG8_WAIT_V(2); PG8_BAR;
        PG8_STAGE(PG8_SB(1, 0), cB + kstep, voffB); PG8_STAGE(PG8_SA(1, 0), cA + kstep, voffA); PG8_STAGE(PG8_SB(1, 1), cB + hstep + kstep, voffB);
        PG8_WAIT_V(6); PG8_BAR;
    } else {
        PG8_STAGE(PG8_SB(0, 0), cB, voffB); PG8_STAGE(PG8_SA(0, 0), cA, voffA); PG8_STAGE(PG8_SB(0, 1), cB + hstep, voffB); PG8_STAGE(PG8_SA(0, 1), cA + hstep, voffA);
        if (wr == 1) PG8_BAR;
        PG8_WAIT_V(4); PG8_BAR;
        PG8_STAGE(PG8_SB(1, 0), cB + kstep, voffB); PG8_STAGE(PG8_SA(1, 0), cA + kstep, voffA); PG8_STAGE(PG8_SB(1, 1), cB + hstep + kstep, voffB);
        PG8_WAIT_V(6); PG8_BAR;
    }
    for (;;) {
        const bool has_next = S.next(ui + 1, nxt);
        const char* nA = has_next ? (const char*)g.A + (size_t)nxt.pm * tstep : cA; const char* nB = has_next ? (const char*)g.Bt + (size_t)nxt.pn * tstep : cB;
        for (int t = 0; t < nt; t += 2) {
            const bool last = (t == nt - 2);
            const char* a1 = cA + (size_t)(t + 1) * kstep;
            const char* a2 = last ? nA : cA + (size_t)(t + 2) * kstep; const char* b2 = last ? nB : cB + (size_t)(t + 2) * kstep;
            const char* a3 = a2 + kstep; const char* b3 = b2 + kstep;
            if (last && has_next) S.a_ready(nxt);
            if constexpr (SP2) {
            PG8_LDB(B0, 0, 0); PG8_LDB(B1, 0, 1); PG8_SCHED; PG8_LDA(At, 0, 0); PG8_STAGE(PG8_SA(1, 1), a1 + hstep, voffA);
            PG8_WAIT_V(8); PG8_WAIT_L(0); PG8_BAR; PG8_MMA(0, 0, At, B0); PG8_MMA(0, 1, At, B1); PG8_BAR; PG8_SCHED;
            PG8_LDA(At, 0, 1); PG8_STAGE(PG8_SB(0, 0), b2, voffB); PG8_STAGE(PG8_SB(0, 1), b2 + hstep, voffB); PG8_STAGE(PG8_SA(0, 0), a2, voffA);
            PG8_WAIT_V(8); PG8_WAIT_L(0); PG8_BAR; PG8_MMA(1, 0, At, B0); PG8_MMA(1, 1, At, B1); PG8_BAR; PG8_SCHED;
            PG8_LDB(B0, 1, 0); PG8_LDB(B1, 1, 1); PG8_SCHED; PG8_LDA(At, 1, 0); PG8_STAGE(PG8_SA(0, 1), a2 + hstep, voffA);
            PG8_WAIT_V(8); PG8_WAIT_L(0); PG8_BAR; PG8_MMA(0, 0, At, B0); PG8_MMA(0, 1, At, B1); PG8_BAR; PG8_SCHED;
            PG8_LDA(At, 1, 1); PG8_STAGE(PG8_SB(1, 0), b3, voffB); PG8_STAGE(PG8_SB(1, 1), b3 + hstep, voffB); PG8_STAGE(PG8_SA(1, 0), a3, voffA);
            PG8_WAIT_V(8); PG8_WAIT_L(0); PG8_BAR; PG8_MMA(1, 0, At, B0); PG8_MMA(1, 1, At, B1); PG8_BAR; PG8_SCHED;
            } else {
            PG8_LDB(B0, 0, 0); PG8_SCHED; PG8_LDA(At, 0, 0); PG8_STAGE(PG8_SA(1, 1), a1 + hstep, voffA);
            PG8_WAIT_L(8); PG8_BAR; PG8_WAIT_L(0); PG8_MMA(0, 0, At, B0); PG8_BAR; PG8_SCHED;
            PG8_LDB(B1, 0, 1); PG8_STAGE(PG8_SB(0, 0), b2, voffB);
            PG8_BAR; PG8_WAIT_L(0); PG8_MMA(0, 1, At, B1); PG8_BAR;
            PG8_LDA(At, 0, 1); PG8_STAGE(PG8_SA(0, 0), a2, voffA);
            PG8_BAR; PG8_WAIT_L(0); PG8_MMA(1, 0, At, B0); PG8_BAR; PG8_SCHED;
            PG8_STAGE(PG8_SB(0, 1), b2 + hstep, voffB);
            PG8_WAIT_V(6); PG8_BAR; PG8_MMA(1, 1, At, B1); PG8_BAR;
            PG8_LDB(B0, 1, 0); PG8_SCHED; PG8_LDA(At, 1, 0); PG8_STAGE(PG8_SA(0, 1), a2 + hstep, voffA);
            PG8_WAIT_L(8); PG8_BAR; PG8_WAIT_L(0); PG8_MMA(0, 0, At, B0); PG8_BAR; PG8_SCHED;
            PG8_LDB(B1, 1, 1); PG8_STAGE(PG8_SB(1, 0), b3, voffB);
            PG8_BAR; PG8_WAIT_L(0); PG8_MMA(0, 1, At, B1); PG8_BAR;
            PG8_LDA(At, 1, 1); PG8_STAGE(PG8_SA(1, 0), a3, voffA);
            PG8_BAR; PG8_WAIT_L(0); PG8_MMA(1, 0, At, B0); PG8_BAR; PG8_SCHED;
            PG8_STAGE(PG8_SB(1, 1), b3 + hstep, voffB);
            PG8_WAIT_V(6); PG8_BAR; PG8_MMA(1, 1, At, B1); PG8_BAR;
            }
        }
        if constexpr (ALIGN_EPI) { if (wr == 0) PG8_BAR; }
        if constexpr (!Epi::AFTER_DRAIN) { E(acc, cur, wr, wc, fr, fq); S.done(cur); }
        if (!has_next) break;
#pragma unroll
        for (int a = 0; a < 2; ++a)
#pragma unroll
            for (int b = 0; b < 2; ++b)
#pragma unroll
                for (int m = 0; m < 4; ++m)
#pragma unroll
                    for (int n = 0; n < 2; ++n) acc[a][b][m][n] = (f32x4){0.f, 0.f, 0.f, 0.f};
        cur = nxt; cA = nA; cB = nB; ++ui;
        if constexpr (ALIGN_EPI) { if (wr == 1) PG8_BAR; }
    }
    PG8_WAIT_V(0);
    if constexpr (!ALIGN_EPI) { if (wr == 0) PG8_BAR; }
    PG8_BAR;
    if constexpr (Epi::AFTER_DRAIN) { E.fused(acc, cur, wr, wc, fr, fq, lds, wid, lane); S.done(cur); }
#undef PG8_SA
#undef PG8_SB
#undef PG8_STAGE
#undef PG8_LDA
#undef PG8_LDB
#undef PG8_MMA
#undef PG8_WAIT_V
#undef PG8_WAIT_L
#undef PG8_BAR
#undef PG8_SCHED
}
}
namespace pg8 {
typedef unsigned u32x2 __attribute__((ext_vector_type(2)));
constexpr float RMS_EPS = 1e-6f;
struct EpiScaleBf16 {
    static constexpr bool PERM = true, AFTER_DRAIN = false;
    bf16_t* O; int ldc; const float* rstd;
    __device__ __forceinline__ void operator()(const f32x4 (&acc)[2][2][4][2], const Unit& u, int wr, int wc, int fr, int fq) const {
        const int row0 = u.pm * BM + wr * 64 + fr, col0 = u.pn * BM + wc * 32 + 8 * fq;
#pragma unroll
        for (int ai = 0; ai < 2; ++ai)
#pragma unroll
            for (int m = 0; m < 4; ++m) { const int row = row0 + ai * HALF + m * 16; const float s = rstd[row]; bf16_t* rowp = O + (size_t)row * ldc + col0;
#pragma unroll
                for (int bj = 0; bj < 2; ++bj) { const f32x4 v0 = acc[ai][bj][m][0] * s, v1 = acc[ai][bj][m][1] * s; u32x4 w;
                    w.x = cvt_pk_bf16(v0[0], v0[1]); w.y = cvt_pk_bf16(v0[2], v0[3]); w.z = cvt_pk_bf16(v1[0], v1[1]); w.w = cvt_pk_bf16(v1[2], v1[3]);
                    *(u32x4*)(rowp + bj * HALF) = w; } }
    }
};
struct EpiRelu2Bf16 {
    static constexpr bool PERM = true, AFTER_DRAIN = false;
    bf16_t* O; int ldc; const float* rowss; int row_off;
    __device__ __forceinline__ void operator()(const f32x4 (&acc)[2][2][4][2], const Unit& u, int wr, int wc, int fr, int fq) const {
        const int row0 = u.pm * BM + wr * 64 + fr, col0 = u.pn * BM + wc * 32 + 8 * fq;
#pragma unroll
        for (int ai = 0; ai < 2; ++ai)
#pragma unroll
            for (int m = 0; m < 4; ++m) { const int row = row0 + ai * HALF + m * 16; const float s = __builtin_amdgcn_rsqf(rowss[row_off + row] * (1.0f / 1024.0f) + RMS_EPS); bf16_t* rowp = O + (size_t)row * ldc + col0;
#pragma unroll
                for (int bj = 0; bj < 2; ++bj) { f32x4 v0 = acc[ai][bj][m][0] * s, v1 = acc[ai][bj][m][1] * s;
#pragma unroll
                    for (int e = 0; e < 4; ++e) { const float a = fmaxf(v0[e], 0.f), b = fmaxf(v1[e], 0.f); v0[e] = a * a; v1[e] = b * b; }
                    u32x4 w; w.x = cvt_pk_bf16(v0[0], v0[1]); w.y = cvt_pk_bf16(v0[2], v0[3]); w.z = cvt_pk_bf16(v1[0], v1[1]); w.w = cvt_pk_bf16(v1[2], v1[3]);
                    *(u32x4*)(rowp + bj * HALF) = w; } }
    }
};
struct EpiResF32 {
    static constexpr bool PERM = false, AFTER_DRAIN = false;
    const float* r0; const float* r1; int split; float* out; bf16_t* ob; float* rowss; int row_off;
    __device__ __forceinline__ void operator()(const f32x4 (&acc)[2][2][4][2], const Unit& u, int wr, int wc, int fr, int fq) const {
        const int col0 = u.pn * BM + wc * 32 + 4 * fq;
#pragma unroll
        for (int ai = 0; ai < 2; ++ai) {
            f32x4 pre[4][2][2];
#pragma unroll
            for (int m = 0; m < 4; ++m) { const int row = row_off + u.pm * BM + ai * HALF + wr * 64 + m * 16 + fr;
                const float* rr = (row < split) ? r0 + (size_t)row * 1024 : r1 + (size_t)(row - split) * 1024;
#pragma unroll
                for (int bj = 0; bj < 2; ++bj)
#pragma unroll
                    for (int n = 0; n < 2; ++n) pre[m][bj][n] = *(const f32x4*)(rr + col0 + bj * HALF + n * 16); }
            asm volatile("" ::: "memory");
#pragma unroll
            for (int m = 0; m < 4; ++m) { const int row = row_off + u.pm * BM + ai * HALF + wr * 64 + m * 16 + fr; float ss = 0.f;
#pragma unroll
                for (int bj = 0; bj < 2; ++bj)
#pragma unroll
                    for (int n = 0; n < 2; ++n) { const int col = col0 + bj * HALF + n * 16; const f32x4 v = pre[m][bj][n] + acc[ai][bj][m][n];
                        *(f32x4*)(out + (size_t)row * 1024 + col) = v; u32x2 w; w.x = cvt_pk_bf16(v[0], v[1]); w.y = cvt_pk_bf16(v[2], v[3]); *(u32x2*)(ob + (size_t)row * 1024 + col) = w;
                        ss += (v[0] * v[0] + v[1] * v[1]) + (v[2] * v[2] + v[3] * v[3]); }
                if (rowss) { ss += __shfl_xor(ss, 16); ss += __shfl_xor(ss, 32); if (fq == 0) atomicAdd(rowss + row, ss); } }
        }
    }
};
struct EpiResBf16 {
    static constexpr bool PERM = true, AFTER_DRAIN = false;
    const float* r0; const float* r1; int split; const bf16_t* rb; bf16_t* ob; float* rowss; int row_off;
    __device__ __forceinline__ void operator()(const f32x4 (&acc)[2][2][4][2], const Unit& u, int wr, int wc, int fr, int fq) const {
        const int col0 = u.pn * BM + wc * 32 + 8 * fq;
#pragma unroll
        for (int ai = 0; ai < 2; ++ai) {
            f32x4 pre[4][2][2];
#pragma unroll
            for (int m = 0; m < 4; ++m) { const int row = row_off + u.pm * BM + ai * HALF + wr * 64 + m * 16 + fr;
                if (rb) {
#pragma unroll
                    for (int bj = 0; bj < 2; ++bj) { const u32x4 w = *(const u32x4*)(rb + (size_t)row * 1024 + col0 + bj * HALF);
                        pre[m][bj][0] = (f32x4){__uint_as_float(w.x << 16), __uint_as_float(w.x & 0xffff0000u), __uint_as_float(w.y << 16), __uint_as_float(w.y & 0xffff0000u)};
                        pre[m][bj][1] = (f32x4){__uint_as_float(w.z << 16), __uint_as_float(w.z & 0xffff0000u), __uint_as_float(w.w << 16), __uint_as_float(w.w & 0xffff0000u)}; }
                } else { const float* rr = (row < split) ? r0 + (size_t)row * 1024 : r1 + (size_t)(row - split) * 1024;
#pragma unroll
                    for (int bj = 0; bj < 2; ++bj)
#pragma unroll
                        for (int n = 0; n < 2; ++n) pre[m][bj][n] = *(const f32x4*)(rr + col0 + bj * HALF + n * 4); } }
            asm volatile("" ::: "memory");
#pragma unroll
            for (int m = 0; m < 4; ++m) { const int row = row_off + u.pm * BM + ai * HALF + wr * 64 + m * 16 + fr; float ss = 0.f;
#pragma unroll
                for (int bj = 0; bj < 2; ++bj) { const f32x4 v0 = pre[m][bj][0] + acc[ai][bj][m][0], v1 = pre[m][bj][1] + acc[ai][bj][m][1];
                    u32x4 w; w.x = cvt_pk_bf16(v0[0], v0[1]); w.y = cvt_pk_bf16(v0[2], v0[3]); w.z = cvt_pk_bf16(v1[0], v1[1]); w.w = cvt_pk_bf16(v1[2], v1[3]);
                    *(u32x4*)(ob + (size_t)row * 1024 + col0 + bj * HALF) = w;
                    ss += (v0[0] * v0[0] + v0[1] * v0[1]) + (v0[2] * v0[2] + v0[3] * v0[3]) + (v1[0] * v1[0] + v1[1] * v1[1]) + (v1[2] * v1[2] + v1[3] * v1[3]); }
                if (rowss) { ss += __shfl_xor(ss, 16); ss += __shfl_xor(ss, 32); if (fq == 0) atomicAdd(rowss + row, ss); } }
        }
    }
};
struct EpiBf16Ss {
    static constexpr bool PERM = true, AFTER_DRAIN = false;
    bf16_t* O; int ldc; float* rowss;
    __device__ __forceinline__ void operator()(const f32x4 (&acc)[2][2][4][2], const Unit& u, int wr, int wc, int fr, int fq) const {
        const int row0 = u.pm * BM + wr * 64 + fr, col0 = u.pn * BM + wc * 32 + 8 * fq;
#pragma unroll
        for (int ai = 0; ai < 2; ++ai)
#pragma unroll
            for (int m = 0; m < 4; ++m) { const int row = row0 + ai * HALF + m * 16; bf16_t* rowp = O + (size_t)row * ldc + col0; float ss = 0.f;
#pragma unroll
                for (int bj = 0; bj < 2; ++bj) { const f32x4 v0 = acc[ai][bj][m][0], v1 = acc[ai][bj][m][1]; u32x4 w;
                    w.x = cvt_pk_bf16(v0[0], v0[1]); w.y = cvt_pk_bf16(v0[2], v0[3]); w.z = cvt_pk_bf16(v1[0], v1[1]); w.w = cvt_pk_bf16(v1[2], v1[3]);
                    *(u32x4*)(rowp + bj * HALF) = w;
                    ss += (v0[0] * v0[0] + v0[1] * v0[1]) + (v0[2] * v0[2] + v0[3] * v0[3]) + (v1[0] * v1[0] + v1[1] * v1[1]) + (v1[2] * v1[2] + v1[3] * v1[3]); }
                ss += __shfl_xor(ss, 16); ss += __shfl_xor(ss, 32); if (fq == 0) atomicAdd(rowss + row, ss); }
    }
};
struct EpiFinal {
    static constexpr bool PERM = true, AFTER_DRAIN = false;
    float* out; const bf16_t* xr; const bf16_t* pp; const float* rowssp; const float* pw;
    __device__ __forceinline__ void operator()(const f32x4 (&acc)[2][2][4][2], const Unit& u, int wr, int wc, int fr, int fq) const {
        const int col0 = u.pn * BM + wc * 32 + 8 * fq;
#pragma unroll
        for (int ai = 0; ai < 2; ++ai)
#pragma unroll
            for (int m = 0; m < 4; ++m) { const int row = u.pm * BM + ai * HALF + wr * 64 + m * 16 + fr; const float s = __builtin_amdgcn_rsqf(rowssp[row] * (1.0f / 1024.0f) + RMS_EPS);
#pragma unroll
                for (int bj = 0; bj < 2; ++bj) { const int col = col0 + bj * HALF; const size_t off = (size_t)row * 1024 + col;
                    const u32x4 xw = *(const u32x4*)(xr + off); const u32x4 pq = *(const u32x4*)(pp + off);
                    const unsigned xa[4] = {xw.x, xw.y, xw.z, xw.w}, pa[4] = {pq.x, pq.y, pq.z, pq.w};
#pragma unroll
                    for (int n = 0; n < 2; ++n) { const f32x4 w = *(const f32x4*)(pw + col + 4 * n); const f32x4 g = acc[ai][bj][m][n]; f32x4 o;
#pragma unroll
                        for (int e2 = 0; e2 < 4; ++e2) { const unsigned xu = xa[2 * n + (e2 >> 1)], pu = pa[2 * n + (e2 >> 1)];
                            const float x = (e2 & 1) ? __uint_as_float(xu & 0xffff0000u) : __uint_as_float(xu << 16), p = (e2 & 1) ? __uint_as_float(pu & 0xffff0000u) : __uint_as_float(pu << 16);
                            const float sg = 1.0f / (1.0f + __expf(-g[e2])); o[e2] = x + sg * p * s * w[e2]; }
                        *(f32x4*)(out + off + 4 * n) = o; } } }
    }
};
}
#define GAS __attribute__((address_space(1)))
#define LAS __attribute__((address_space(3)))
typedef unsigned short bf16;
typedef float f32x4 __attribute__((ext_vector_type(4)));
typedef float f32x16 __attribute__((ext_vector_type(16)));
typedef short bf16x8 __attribute__((ext_vector_type(8)));
typedef short s16x4 __attribute__((ext_vector_type(4)));
typedef unsigned u32x4 __attribute__((ext_vector_type(4)));
typedef unsigned u32x2 __attribute__((ext_vector_type(2)));
constexpr int DM = 1024, LP = 8192, BP = 4, LS = 2048, BS = 8, MP = BP * LP, MS = BS * LS, MT = MP + MS;
constexpr int NIN = 2048, IN_COLS = 1952, HYW = 512, QLORA = 256, KVLORA = 128, NH = 8, QKD = 96, DFF = 4096, PLE = 256;
constexpr int COL_Q = 1536, COL_KV = 1792, COL_KR = 1920;
constexpr float EPS = 1e-6f;
constexpr float QSCALE = 0.10206207261596575f * 1.4426950408889634f;
constexpr int NWAVES = 8, NTHR = 512;
constexpr int KVT_BYTES = 20480, KT_BYTES = 12288;
constexpr size_t QS_OFF = (size_t)32 * LP * QKD;
constexpr size_t KVS_OFF = (size_t)32 * (LP / 64) * KVT_BYTES;
constexpr size_t MiB = 1u << 20;
constexpr size_t WS_CTL = 0, CTL_ZERO_BYTES = 1 * MiB;
constexpr size_t WS_ROWSS1 = 256 * 1024, WS_ROWSSP = 512 * 1024;
constexpr size_t WS_RSTD0 = 1 * MiB, WS_TW = 1 * MiB + 256 * 1024, WS_ROPE = 2 * MiB, WS_H2P = 3 * MiB, WS_H2S = 5 * MiB + 512 * 1024;
constexpr size_t WS_WIN = 8 * MiB, WS_WQB = 12 * MiB, WS_WKVB = 12 * MiB + 512 * 1024, WS_WOUT = 13 * MiB, WS_W1 = 15 * MiB, WS_W2 = 23 * MiB, WS_WG = 31 * MiB, WS_WPP = 33 * MiB;
constexpr size_t WS_PB = 34 * MiB;
constexpr size_t WS_A = 58 * MiB;
constexpr size_t WS_B = 154 * MiB;
constexpr size_t WS_YMLA = WS_B, WS_MIX = WS_B + 96 * MiB, WS_KSPEC = WS_MIX, WS_HMID = WS_B, WS_PP = WS_B + 128 * MiB;
constexpr size_t WS_C = 346 * MiB;
constexpr size_t WS_KERNP = 466 * MiB, WS_KERNS = 498 * MiB;
constexpr size_t WS_END = 506 * MiB;
constexpr int CW_BAR = 4096;
static_assert((16384 + 16384 / 16) * 8 <= 131072 + 8192 && 4 * (4096 + 4096 / 16) * 8 <= 131072 + 8192, "padded FFT image must end below the LDS control words");
constexpr int RING_BYTES = 131072, LDSX_OFF = RING_BYTES  , LDSCTL_OFF = RING_BYTES + 8192, MISC_OFF = LDSCTL_OFF + 320, LDS_BYTES = 147456;

#define LDS_WAIT() asm volatile("s_waitcnt lgkmcnt(0)" ::: "memory")
#define VM_WAIT() asm volatile("s_waitcnt vmcnt(0)" ::: "memory")
__device__ __forceinline__ unsigned f2bf(float f) { unsigned u = __builtin_bit_cast(unsigned, f); return (u + 0x7fffu + ((u >> 16) & 1u)) >> 16; }
__device__ __forceinline__ unsigned pk2(float lo, float hi) { return f2bf(lo) | (f2bf(hi) << 16); }
__device__ __forceinline__ float bf2f(unsigned h) { return __uint_as_float(h << 16); }
__device__ __forceinline__ float wave_sum(float v) {
#pragma unroll
    for (int o = 1; o < 64; o <<= 1) v += __shfl_xor(v, o);
    return v;
}
__device__ __forceinline__ int crow(int r, int hi) { return (r & 3) + 8 * (r >> 2) + 4 * hi; }
__device__ __forceinline__ float fadd_s(float a, float b) { float r; asm("v_add_f32_e32 %0, %1, %2" : "=v"(r) : "v"(a), "v"(b)); return r; }
__device__ __forceinline__ float fsub_s(float a, float b) { float r; asm("v_sub_f32_e32 %0, %1, %2" : "=v"(r) : "v"(a), "v"(b)); return r; }
__device__ __forceinline__ float fmul_s(float a, float b) { float r; asm("v_mul_f32_e32 %0, %1, %2" : "=v"(r) : "v"(a), "v"(b)); return r; }
__device__ __forceinline__ float ffma_s(float a, float b, float c) { float r; asm("v_fma_f32 %0, %1, %2, %3" : "=v"(r) : "v"(a), "v"(b), "v"(c)); return r; }
__device__ __forceinline__ float ffms_s(float a, float b, float c) { float r; asm("v_fma_f32 %0, %1, %2, -%3" : "=v"(r) : "v"(a), "v"(b), "v"(c)); return r; }

struct Args { const float* in[30]; float* out; unsigned char* ws; int ph_lo, ph_hi; };
struct Frame {
    unsigned char* lds;
    int wave, vcu, G;
    const float* in[30]; float* out; unsigned char* ws;
};
__device__ __forceinline__ const float* xrow(const Frame& F, int m) { return m < MP ? F.in[0] + (size_t)m * DM : F.in[1] + (size_t)(m - MP) * DM; }
__device__ __forceinline__ const float* prow(const Frame& F, int m) { return m < MP ? F.in[2] + (size_t)m * PLE : F.in[3] + (size_t)(m - MP) * PLE; }

__device__ __forceinline__ void p0_transpose_item(const float* W, int K, int N, bf16* WT, const float* sc, float* scr, int item, int lane, int R = 0) {
    const int nblk = N / 32, kb = item / nblk, nb = item % nblk, k0 = 64 * kb, n0 = 32 * nb;
#pragma unroll
    for (int i = 0; i < 32; ++i) { const int kk = 2 * i + (lane >> 5); float v = W[(size_t)(k0 + kk) * N + n0 + (lane & 31)]; if (sc) v *= sc[k0 + kk]; scr[kk * 33 + (lane & 31)] = v; }
    LDS_WAIT(); asm volatile("" ::: "memory");
    const int c = lane & 7;
#pragma unroll
    for (int j = 0; j < 4; ++j) { const int n = (lane >> 3) + 8 * j; const float* s = scr + (8 * c) * 33 + n;
        u32x4 o; o.x = pk2(s[0 * 33], s[1 * 33]); o.y = pk2(s[2 * 33], s[3 * 33]); o.z = pk2(s[4 * 33], s[5 * 33]); o.w = pk2(s[6 * 33], s[7 * 33]);
        if (R == 0) *(u32x4*)(WT + (size_t)(n0 + n) * K + k0 + 8 * c) = o;
        else { const int nn = n0 + n, h = nn / R, ft = (nn % R) >> 5, r32 = nn & 31, kc = (k0 >> 3) + c, ks = kc >> 1, hh = kc & 1, nks = K >> 4;
            *(u32x4*)(WT + ((size_t)(((h * (R >> 5) + ft) * nks + ks) * 64 + hh * 32 + r32)) * 8) = o; } }
    LDS_WAIT(); asm volatile("" ::: "memory");
}
__device__ __forceinline__ void p0_prologue(Frame& F) {
    float* scr = (float*)(F.lds + F.wave * 16384);
    const int gw = F.vcu * NWAVES + F.wave, NGW = F.G * NWAVES, lane = ((int)threadIdx.x & 63);
    unsigned char* ws = F.ws;
    constexpr int I_IN = 16 * 61, I_QB = 4 * 24, I_KVB = 2 * 32, I_OUT = 16 * 32, I_1 = 16 * 128, I_2 = 64 * 32, I_G = 16 * 32, I_PP = 4 * 32;
    constexpr int NITEMS = I_IN + I_QB + I_KVB + I_OUT + I_1 + I_2 + I_G + I_PP;
    for (int it = gw; it < NITEMS; it += NGW) {
        int r = it;
        if (r < I_IN) { p0_transpose_item(F.in[5], 1024, IN_COLS, (bf16*)(ws + WS_WIN), F.in[4], scr, r, lane); continue; } r -= I_IN;
        if (r < I_QB) { p0_transpose_item(F.in[16], QLORA, 768, (bf16*)(ws + WS_WQB), F.in[15], scr, r, lane, QKD); continue; } r -= I_QB;
        if (r < I_KVB) { p0_transpose_item(F.in[18], KVLORA, 1024, (bf16*)(ws + WS_WKVB), F.in[17], scr, r, lane, 128); continue; } r -= I_KVB;
        if (r < I_OUT) { p0_transpose_item(F.in[23], 1024, 1024, (bf16*)(ws + WS_WOUT), nullptr, scr, r, lane); continue; } r -= I_OUT;
        if (r < I_1) { p0_transpose_item(F.in[25], 1024, DFF, (bf16*)(ws + WS_W1), F.in[24], scr, r, lane); continue; } r -= I_1;
        if (r < I_2) { p0_transpose_item(F.in[26], DFF, 1024, (bf16*)(ws + WS_W2), nullptr, scr, r, lane); continue; } r -= I_2;
        if (r < I_G) { p0_transpose_item(F.in[27], 1024, 1024, (bf16*)(ws + WS_WG), nullptr, scr, r, lane); continue; } r -= I_G;
        p0_transpose_item(F.in[28], PLE, 1024, (bf16*)(ws + WS_WPP), nullptr, scr, r, lane);
    }
    { u32x4* z = (u32x4*)(ws + WS_WIN + (size_t)IN_COLS * 1024 * 2); const int n16 = (NIN - IN_COLS) * 1024 * 2 / 16;
      for (int i = (F.vcu * NTHR + ((int)threadIdx.x)); i < n16; i += F.G * NTHR) z[i] = (u32x4){0u, 0u, 0u, 0u}; }
    bf16* xb = (bf16*)(ws + WS_A); float* rstd0 = (float*)(ws + WS_RSTD0); bf16* pb = (bf16*)(ws + WS_PB);
#pragma unroll 8
    for (int m = gw; m < MT; m += NGW) {
        const f32x4* xr = (const f32x4*)xrow(F, m) + lane; f32x4 v[4]; float s = 0.f;
#pragma unroll
        for (int j = 0; j < 4; ++j) { v[j] = xr[64 * j]; s += (v[j].x * v[j].x + v[j].y * v[j].y) + (v[j].z * v[j].z + v[j].w * v[j].w); }
        s = wave_sum(s);
        if (lane == 0) rstd0[m] = 1.0f / sqrtf(s * (1.0f / DM) + EPS);
        u32x2* o8 = (u32x2*)(xb + (size_t)m * DM) + lane;
#pragma unroll
        for (int j = 0; j < 4; ++j) { u32x2 w; w.x = pk2(v[j].x, v[j].y); w.y = pk2(v[j].z, v[j].w); o8[64 * j] = w; }
        const f32x4 pv = ((const f32x4*)prow(F, m))[lane]; u32x2 w; w.x = pk2(pv.x, pv.y); w.y = pk2(pv.z, pv.w); ((u32x2*)(pb + (size_t)m * PLE))[lane] = w;
    }
    { float2* tw = (float2*)(ws + WS_TW); float2* rope = (float2*)(ws + WS_ROPE);
      for (int i = F.vcu * NTHR + ((int)threadIdx.x); i < 16384; i += F.G * NTHR) { float sn, cs; sincospif((float)i * (1.0f / 8192.0f), &sn, &cs); tw[i] = make_float2(cs, -sn); }
      for (int i = F.vcu * NTHR + ((int)threadIdx.x); i < LP * 16; i += F.G * NTHR) { const int t = i >> 4, k = i & 15; const float inv = powf(10000.0f, -(2.0f * (float)k) / 32.0f); const float ang = (float)t * inv;
          float sn, cs; sincosf(ang, &sn, &cs); rope[i] = make_float2(cs, sn); } }
    { const float* w1 = F.in[8]; const float* b1 = F.in[9]; const float* fq = F.in[10]; const float* w2 = F.in[11]; const float* b2 = F.in[12];
      const float freq = fq[lane], bb1 = b1[lane], bb2 = b2[lane];
      for (int pos = gw; pos < LP + LS; pos += NGW) {
          const int L = pos < LP ? LP : LS, j = pos < LP ? pos : pos - LP;
          const float t = (float)j * (1.0f / (float)(L - 1)); const float w = (6.283185307179586f * (float)j) / (float)L;
          float zv = 0.f;
          if (lane == 0) zv = t;
          else if (lane <= 16) { const float f = 1e-4f + (float)(lane - 1) * ((15.0f - 1e-4f) / 15.0f); zv = cosf(f * w); }
          else if (lane <= 32) { const float f = 1e-4f + (float)(lane - 17) * ((15.0f - 1e-4f) / 15.0f); zv = -sinf(f * w); }
          float a1 = bb1;
          for (int i = 0; i < 33; ++i) a1 += __shfl(zv, i) * w1[i * 64 + lane];
          const float h1 = sinf(freq * a1);
          float a2 = bb2;
          for (int k = 0; k < 64; ++k) a2 += __shfl(h1, k) * w2[k * 64 + lane];
          const float h2 = sinf(freq * a2);
          float* dst = (pos < LP) ? (float*)(ws + WS_H2P) + (size_t)lane * LP + j : (float*)(ws + WS_H2S) + (size_t)lane * LS + j;
          *dst = h2;
      } }
}

__device__ __forceinline__ void p2_mla_tile(Frame& F, int tile) {
    const int lane = ((int)threadIdx.x & 63), wid = F.wave, r32 = lane & 31, hi = lane >> 5;
    unsigned char* lds = F.lds;
    unsigned char* LQ = lds; unsigned char* LKV = lds + 32768; unsigned char* LKR = lds + 49152; float* RS = (float*)(lds + 53248);
    const bf16* proj = (const bf16*)(F.ws + WS_B);
    const int m0 = tile * 64;
#pragma unroll 2
    for (int i = 0; i < 8; ++i) { const int tok = wid * 8 + i; float ss = 0.f;
        if (lane < 52) { const u32x4 v = *(const u32x4*)(proj + (size_t)(m0 + tok) * NIN + COL_Q + lane * 8);
            const unsigned w[4] = {v.x, v.y, v.z, v.w};
#pragma unroll
            for (int e = 0; e < 4; ++e) { const float a = __uint_as_float(w[e] << 16), b = __uint_as_float(w[e] & 0xffff0000u); ss += a * a + b * b; }
            unsigned char* dst = lane < 32 ? LQ + (lane * 64 + tok) * 16 : (lane < 48 ? LKV + ((lane - 32) * 64 + tok) * 16 : LKR + tok * 64 + (lane - 48) * 16);
            *(u32x4*)dst = v; }
        const float sq = wave_sum(lane < 32 ? ss : 0.f), skv = wave_sum((lane >= 32 && lane < 48) ? ss : 0.f);
        if (lane == 0) { RS[tok] = 1.0f / sqrtf(sq * (1.0f / QLORA) + EPS); RS[64 + tok] = 1.0f / sqrtf(skv * (1.0f / KVLORA) + EPS); } }
    __syncthreads();
    int b, t0, L; size_t qoff; size_t kvoff;
    if (m0 < MP) { b = m0 / LP; t0 = m0 % LP; L = LP; qoff = ((size_t)(b * NH + wid) * LP + t0) * QKD; kvoff = ((size_t)(b * NH + wid) * (LP / 64) + t0 / 64) * KVT_BYTES; }
    else { const int mm = m0 - MP; b = mm / LS; t0 = mm % LS; L = LS; qoff = QS_OFF + ((size_t)(b * NH + wid) * LS + t0) * QKD; kvoff = KVS_OFF + ((size_t)(b * NH + wid) * (LS / 64) + t0 / 64) * KVT_BYTES; }
    (void)L;
    const float2* rope = (const float2*)(F.ws + WS_ROPE);
#pragma unroll 1
    for (int tb = 0; tb < 2; ++tb) {
        const bf16* wq = (const bf16*)(F.ws + WS_WQB) + ((size_t)(wid * 3) * 16 * 64 + lane) * 8;
        const int tok = tb * 32 + r32;
        f32x16 acc[3];
#pragma unroll
        for (int a = 0; a < 3; ++a) acc[a] = (f32x16){};
#pragma unroll 2
        for (int ks = 0; ks < 16; ++ks) {
            const bf16x8 b0 = *(const bf16x8*)(LQ + ((2 * ks + hi) * 64 + tok) * 16);
#pragma unroll
            for (int ft = 0; ft < 3; ++ft) { const bf16x8 a = *(const bf16x8*)(wq + (size_t)((ft * 16 + ks) * 64) * 8);
                acc[ft] = __builtin_amdgcn_mfma_f32_32x32x16_bf16(a, b0, acc[ft], 0, 0, 0); }
        }
        const float* qnw = F.in[19];
        bf16* qr = (bf16*)(F.ws + WS_A) + qoff + (size_t)tok * QKD;
        const float s = RS[tok]; float ss = 0.f;
#pragma unroll
        for (int ft = 0; ft < 3; ++ft)
#pragma unroll
            for (int r = 0; r < 16; ++r) { const float v = acc[ft][r] * s; acc[ft][r] = v; ss += v * v; }
        ss += __shfl_xor(ss, 32);
        const float rq = 1.0f / sqrtf(ss * (1.0f / QKD) + EPS);
#pragma unroll
        for (int ft = 0; ft < 3; ++ft)
#pragma unroll
            for (int r = 0; r < 16; ++r) acc[ft][r] *= rq * qnw[32 * ft + crow(r, hi)];
#pragma unroll
        for (int r = 0; r < 8; ++r) { const float2 cs = rope[(size_t)(t0 + tok) * 16 + crow(r, hi)]; const float a = acc[2][r], bq = acc[2][r + 8];
            acc[2][r] = a * cs.x - bq * cs.y; acc[2][r + 8] = a * cs.y + bq * cs.x; }
#pragma unroll
        for (int ft = 0; ft < 3; ++ft)
#pragma unroll
            for (int g = 0; g < 4; ++g) { u32x2 w; w.x = pk2(acc[ft][4 * g] * QSCALE, acc[ft][4 * g + 1] * QSCALE); w.y = pk2(acc[ft][4 * g + 2] * QSCALE, acc[ft][4 * g + 3] * QSCALE);
                *(u32x2*)(qr + 32 * ft + 8 * g + 4 * hi) = w; }
    }
#pragma unroll 1
    for (int it = 0; it < 4; ++it) {
        const int half = it >> 1, tb = it & 1, tok = tb * 32 + r32;
        const bf16* wkv = (const bf16*)(F.ws + WS_WKVB) + ((size_t)((wid * 4 + half * 2) * 8) * 64 + lane) * 8;
        const float* knw = F.in[20];
        unsigned char* KT = F.ws + WS_C + kvoff;
        f32x16 acc[2];
        acc[0] = (f32x16){}; acc[1] = (f32x16){};
#pragma unroll 2
        for (int ks = 0; ks < 8; ++ks) {
            const bf16x8 b0 = *(const bf16x8*)(LKV + ((2 * ks + hi) * 64 + tok) * 16);
#pragma unroll
            for (int ft = 0; ft < 2; ++ft) { const bf16x8 a = *(const bf16x8*)(wkv + (size_t)((ft * 8 + ks) * 64) * 8);
                acc[ft] = __builtin_amdgcn_mfma_f32_32x32x16_bf16(a, b0, acc[ft], 0, 0, 0); }
        }
        const float s = RS[64 + tok];
        if (half == 0) {
            float ss = 0.f;
#pragma unroll
            for (int ft = 0; ft < 2; ++ft)
#pragma unroll
                for (int r = 0; r < 16; ++r) { const float v = acc[ft][r] * s; acc[ft][r] = v; ss += v * v; }
            const u32x4 ka = *(const u32x4*)(LKR + tok * 64 + hi * 16), kb = *(const u32x4*)(LKR + tok * 64 + 32 + hi * 16);
            float fa[8], fb[8]; { const unsigned wa[4] = {ka.x, ka.y, ka.z, ka.w}, wb[4] = {kb.x, kb.y, kb.z, kb.w};
#pragma unroll
                for (int e = 0; e < 4; ++e) { fa[2 * e] = __uint_as_float(wa[e] << 16); fa[2 * e + 1] = __uint_as_float(wa[e] & 0xffff0000u); fb[2 * e] = __uint_as_float(wb[e] << 16); fb[2 * e + 1] = __uint_as_float(wb[e] & 0xffff0000u); } }
#pragma unroll
            for (int j = 0; j < 8; ++j) ss += fa[j] * fa[j] + fb[j] * fb[j];
            ss += __shfl_xor(ss, 32);
            const float rk = 1.0f / sqrtf(ss * (1.0f / QKD) + EPS);
#pragma unroll
            for (int ft = 0; ft < 2; ++ft)
#pragma unroll
                for (int g = 0; g < 4; ++g) { float v[4];
#pragma unroll
                    for (int e = 0; e < 4; ++e) v[e] = acc[ft][4 * g + e] * rk * knw[32 * ft + 8 * g + 4 * hi + e];
                    u32x2 w; w.x = pk2(v[0], v[1]); w.y = pk2(v[2], v[3]);
                    *(u32x2*)(KT + (((4 * ft + g) * 64 + tok) * 8 + 4 * hi) * 2) = w; }
            { float oa[8], ob[8];
#pragma unroll
              for (int j = 0; j < 8; ++j) { const int i = 8 * hi + j; const float2 cs = rope[(size_t)(t0 + tok) * 16 + i]; const float a = fa[j] * rk * knw[64 + i], bq = fb[j] * rk * knw[80 + i];
                  oa[j] = a * cs.x - bq * cs.y; ob[j] = a * cs.y + bq * cs.x; }
              u32x4 wa, wb; wa.x = pk2(oa[0], oa[1]); wa.y = pk2(oa[2], oa[3]); wa.z = pk2(oa[4], oa[5]); wa.w = pk2(oa[6], oa[7]); wb.x = pk2(ob[0], ob[1]); wb.y = pk2(ob[2], ob[3]); wb.z = pk2(ob[4], ob[5]); wb.w = pk2(ob[6], ob[7]);
              *(u32x4*)(KT + ((8 + hi) * 64 + tok) * 16) = wa; *(u32x4*)(KT + ((10 + hi) * 64 + tok) * 16) = wb; }
        } else {
#pragma unroll
            for (int ft = 0; ft < 2; ++ft)
#pragma unroll
                for (int g = 0; g < 4; ++g) { u32x2 w; w.x = pk2(acc[ft][4 * g] * s, acc[ft][4 * g + 1] * s); w.y = pk2(acc[ft][4 * g + 2] * s, acc[ft][4 * g + 3] * s);
                    *(u32x2*)(KT + KT_BYTES + ((ft * 64 + tok) * 32 + 8 * g + 4 * hi) * 2) = w; }
        }
    }
    __syncthreads();
}
__device__ __forceinline__ void p2_mla_wg(Frame& F, int u) {
    const int tid = (int)threadIdx.x, lane = tid & 63, wid = F.wave, r32 = lane & 31, hi = lane >> 5;
    unsigned char* lds = F.lds;
    const bf16* proj = (const bf16*)(F.ws + WS_B);
    const bool comp = wid < 6;
    const int mb = u * 192 + (comp ? wid : 0) * 32;
    int b, t0, L; size_t qbase, kvbase;
    if (mb < MP) { b = mb / LP; t0 = mb % LP; L = LP; qbase = (size_t)(b * NH) * LP * QKD; kvbase = (size_t)(b * NH) * (LP / 64) * KVT_BYTES; }
    else { const int mm = mb - MP; b = mm / LS; t0 = mm % LS; L = LS; qbase = QS_OFF + (size_t)(b * NH) * LS * QKD; kvbase = KVS_OFF + (size_t)(b * NH) * (LS / 64) * KVT_BYTES; }
    const int tk = (t0 & 63) + r32;
    const float2* rope = (const float2*)(F.ws + WS_ROPE);
    int hi8 = 8 * hi; asm volatile("" : "+v"(hi8));
    const bf16* row = proj + (size_t)(mb + r32) * NIN + hi8;
    const float* qnw = F.in[19]; const float* knw = F.in[20];
    const unsigned lds0 = (unsigned)(uintptr_t)lds;
#define P2_GLDS(gsrc_, ldst_) do { unsigned keep_; asm volatile("s_mov_b32 %0, m0\n\ts_mov_b32 m0, %2\n\ts_nop 0\n\tglobal_load_lds_dwordx4 %1, off\n\ts_mov_b32 m0, %0" : "=&s"(keep_) : "v"(gsrc_), "s"(ldst_) : "memory"); } while (0)
#define P2_DMA(ci_) do { const int c_ = (ci_); const int np_ = c_ < 8 ? 6 : 4; unsigned lo2_ = (unsigned)lane * 16u; asm volatile("" : "+v"(lo2_)); \
        const unsigned char* g_ = chunk_src(c_) + wid * 1024 + lo2_; const unsigned l_ = (unsigned)__builtin_amdgcn_readfirstlane((int)(lds0 + (c_ & 1) * 49152 + wid * 1024)); \
        _Pragma("unroll") for (int j_ = 0; j_ < 6; ++j_) if (j_ < np_) P2_GLDS(g_ + j_ * 8192, l_ + (unsigned)(j_ * 8192)); } while (0)
    auto chunk_src = [&](int i) -> const unsigned char* { return i < 8 ? F.ws + WS_WQB + (size_t)i * 49152 : F.ws + WS_WKVB + (size_t)(i - 8) * 32768; };
    float* nwl = (float*)(lds + 98304);
    if (tid < 96) nwl[tid] = qnw[tid]; else if (tid < 192) nwl[tid] = knw[tid - 96];
    P2_DMA(0);
    asm volatile("s_waitcnt vmcnt(0)" ::: "memory");
    __syncthreads();
    {
        bf16x8 bq[16]; float rsq; float2 ropq[8];
#pragma unroll
        for (int r = 0; r < 8; ++r) ropq[r] = rope[(size_t)(t0 + r32) * 16 + crow(r, hi)];
        { float sq = 0.f;
#pragma unroll
          for (int ks = 0; ks < 16; ++ks) { bq[ks] = *(const bf16x8*)(row + COL_Q + 16 * ks);
#pragma unroll
              for (int j = 0; j < 8; ++j) { const float v = bf2f((unsigned short)bq[ks][j]); sq += v * v; } }
          sq += __shfl_xor(sq, 32); rsq = 1.0f / sqrtf(sq * (1.0f / QLORA) + EPS); }
#pragma unroll 1
        for (int i = 0; i < 8; ++i) {
            const unsigned char* wl = lds + (i & 1) * 49152;
            P2_DMA(i + 1);
            if (comp) {
                unsigned lo_ = (unsigned)lane * 16u; asm volatile("" : "+v"(lo_)); const unsigned char* wll = wl + lo_;
                const int h = i; f32x16 acc[3];
#pragma unroll
                for (int a = 0; a < 3; ++a) acc[a] = (f32x16){};
#pragma unroll
                for (int ks = 0; ks < 16; ++ks) {
#pragma unroll
                    for (int ft = 0; ft < 3; ++ft) { const bf16x8 a = *(const bf16x8*)(wll + ((ft * 16 + ks) * 64) * 16); acc[ft] = __builtin_amdgcn_mfma_f32_32x32x16_bf16(a, bq[ks], acc[ft], 0, 0, 0); }
                    if ((ks & 3) == 3) __builtin_amdgcn_sched_barrier(0);
                }
                float ss = 0.f;
#pragma unroll
                for (int ft = 0; ft < 3; ++ft)
#pragma unroll
                    for (int r = 0; r < 16; ++r) { const float v = acc[ft][r] * rsq; acc[ft][r] = v; ss += v * v; }
                ss += __shfl_xor(ss, 32);
                const float rq = 1.0f / sqrtf(ss * (1.0f / QKD) + EPS);
#pragma unroll
                for (int ft = 0; ft < 3; ++ft)
#pragma unroll
                    for (int g = 0; g < 4; ++g) { const f32x4 w4 = *(const f32x4*)(nwl + 32 * ft + 8 * g + 4 * hi);
#pragma unroll
                        for (int e2 = 0; e2 < 4; ++e2) acc[ft][4 * g + e2] *= rq * w4[e2]; }
#pragma unroll
                for (int r = 0; r < 8; ++r) { const float2 cs = ropq[r]; const float a = acc[2][r], bqv = acc[2][r + 8];
                    acc[2][r] = a * cs.x - bqv * cs.y; acc[2][r + 8] = a * cs.y + bqv * cs.x; }
                bf16* qr = (bf16*)(F.ws + WS_A) + qbase + ((size_t)h * L + t0 + r32) * QKD;
#pragma unroll
                for (int ft = 0; ft < 3; ++ft)
#pragma unroll
                    for (int g = 0; g < 4; ++g) { u32x2 w; w.x = pk2(acc[ft][4 * g] * QSCALE, acc[ft][4 * g + 1] * QSCALE); w.y = pk2(acc[ft][4 * g + 2] * QSCALE, acc[ft][4 * g + 3] * QSCALE);
                        *(u32x2*)(qr + 32 * ft + 8 * g + 4 * hi) = w; }
            }
            asm volatile("s_waitcnt vmcnt(0)" ::: "memory");
            __syncthreads();
        }
    }
    {
        bf16x8 bkv[8]; float rskv; float fa[8], fb[8]; float ssr = 0.f; float2 ropk[8];
#pragma unroll
        for (int j = 0; j < 8; ++j) ropk[j] = rope[(size_t)(t0 + r32) * 16 + 8 * hi + j];
        { float skv = 0.f;
#pragma unroll
          for (int ks = 0; ks < 8; ++ks) { bkv[ks] = *(const bf16x8*)(row + COL_KV + 16 * ks);
#pragma unroll
              for (int j = 0; j < 8; ++j) { const float v = bf2f((unsigned short)bkv[ks][j]); skv += v * v; } }
          skv += __shfl_xor(skv, 32); rskv = 1.0f / sqrtf(skv * (1.0f / KVLORA) + EPS);
          const u32x4 kra = *(const u32x4*)(row + COL_KR), krb = *(const u32x4*)(row + COL_KR + 16);
          const unsigned wa[4] = {kra.x, kra.y, kra.z, kra.w}, wb[4] = {krb.x, krb.y, krb.z, krb.w};
#pragma unroll
          for (int e = 0; e < 4; ++e) { fa[2 * e] = __uint_as_float(wa[e] << 16); fa[2 * e + 1] = __uint_as_float(wa[e] & 0xffff0000u); fb[2 * e] = __uint_as_float(wb[e] << 16); fb[2 * e + 1] = __uint_as_float(wb[e] & 0xffff0000u); }
#pragma unroll
          for (int j = 0; j < 8; ++j) ssr += fa[j] * fa[j] + fb[j] * fb[j]; }
#pragma unroll 1
        for (int i = 8; i < 16; ++i) {
            const unsigned char* wl = lds + (i & 1) * 49152;
            if (i + 1 < 16) P2_DMA(i + 1);
            if (comp) {
                unsigned lo_ = (unsigned)lane * 16u; asm volatile("" : "+v"(lo_)); const unsigned char* wll = wl + lo_;
                const int h = i - 8; f32x16 acc[4]; const float* knl = nwl + 96;
#pragma unroll
                for (int a = 0; a < 4; ++a) acc[a] = (f32x16){};
#pragma unroll
                for (int ks = 0; ks < 8; ++ks) {
#pragma unroll
                    for (int ft = 0; ft < 4; ++ft) { const bf16x8 a = *(const bf16x8*)(wll + ((ft * 8 + ks) * 64) * 16); acc[ft] = __builtin_amdgcn_mfma_f32_32x32x16_bf16(a, bkv[ks], acc[ft], 0, 0, 0); }
                    if ((ks & 1) == 1) __builtin_amdgcn_sched_barrier(0);
                }
                unsigned char* KT = F.ws + WS_C + kvbase + ((size_t)h * (L / 64) + (t0 >> 6)) * KVT_BYTES;
                float ss = ssr;
#pragma unroll
                for (int ft = 0; ft < 2; ++ft)
#pragma unroll
                    for (int r = 0; r < 16; ++r) { const float v = acc[ft][r] * rskv; acc[ft][r] = v; ss += v * v; }
                ss += __shfl_xor(ss, 32);
                const float rk = 1.0f / sqrtf(ss * (1.0f / QKD) + EPS);
#pragma unroll
                for (int ft = 0; ft < 2; ++ft)
#pragma unroll
                    for (int g = 0; g < 4; ++g) { float v[4]; const f32x4 w4 = *(const f32x4*)(knl + 32 * ft + 8 * g + 4 * hi);
#pragma unroll
                        for (int e = 0; e < 4; ++e) v[e] = acc[ft][4 * g + e] * rk * w4[e];
                        u32x2 w; w.x = pk2(v[0], v[1]); w.y = pk2(v[2], v[3]);
                        *(u32x2*)(KT + (((4 * ft + g) * 64 + tk) * 8 + 4 * hi) * 2) = w; }
                { float oa[8], ob[8];
#pragma unroll
                  for (int j = 0; j < 8; ++j) { const int ii = 8 * hi + j; const float2 cs = ropk[j]; const float a = fa[j] * rk * knl[64 + ii], bqv = fb[j] * rk * knl[80 + ii];
                      oa[j] = a * cs.x - bqv * cs.y; ob[j] = a * cs.y + bqv * cs.x; }
                  u32x4 wa2, wb2; wa2.x = pk2(oa[0], oa[1]); wa2.y = pk2(oa[2], oa[3]); wa2.z = pk2(oa[4], oa[5]); wa2.w = pk2(oa[6], oa[7]); wb2.x = pk2(ob[0], ob[1]); wb2.y = pk2(ob[2], ob[3]); wb2.z = pk2(ob[4], ob[5]); wb2.w = pk2(ob[6], ob[7]);
                  *(u32x4*)(KT + ((8 + hi) * 64 + tk) * 16) = wa2; *(u32x4*)(KT + ((10 + hi) * 64 + tk) * 16) = wb2; }
#pragma unroll
                for (int ft = 2; ft < 4; ++ft)
#pragma unroll
                    for (int g = 0; g < 4; ++g) { u32x2 w; w.x = pk2(acc[ft][4 * g] * rskv, acc[ft][4 * g + 1] * rskv); w.y = pk2(acc[ft][4 * g + 2] * rskv, acc[ft][4 * g + 3] * rskv);
                        *(u32x2*)(KT + KT_BYTES + (((ft - 2) * 64 + tk) * 32 + 8 * g + 4 * hi) * 2) = w; }
            }
            asm volatile("s_waitcnt vmcnt(0)" ::: "memory");
            __syncthreads();
        }
    }
}
#undef P2_GLDS
#undef P2_DMA
__device__ __forceinline__ void p2_hyena_front(Frame& F, int unit) {
    const int c = ((int)threadIdx.x); const int m0 = unit * 32;
    int b, t0, L; bf16* zt; bf16* x0t;
    bf16* zbase = (bf16*)F.out; bf16* xbase = (bf16*)(F.out + (size_t)MT * HYW);
    if (m0 < MP) { b = m0 / LP; t0 = m0 % LP; L = LP; zt = zbase + ((size_t)(b * HYW + c) * LP + t0); x0t = xbase + ((size_t)(b * HYW + c) * LP + t0); }
    else { const int mm = m0 - MP; b = mm / LS; t0 = mm % LS; L = LS; zt = zbase + (size_t)MP * HYW + ((size_t)(b * HYW + c) * LS + t0); x0t = xbase + (size_t)MP * HYW + ((size_t)(b * HYW + c) * LS + t0); }
    const bf16* proj = (const bf16*)(F.ws + WS_B) + (size_t)(m0 - t0) * NIN;
    const float* cw = F.in[6]; const float* cb = F.in[7];
    float w0[3], w1[3], w2[3], bb[3];
#pragma unroll
    for (int s = 0; s < 3; ++s) { w0[s] = cw[0 * 1536 + s * 512 + c]; w1[s] = cw[1 * 1536 + s * 512 + c]; w2[s] = cw[2 * 1536 + s * 512 + c]; bb[s] = cb[s * 512 + c]; }
    float pv[3], cv[3], nv[3];
    auto ld = [&](int t, float (&d)[3]) { const bool ok = (t >= 0) && (t < L); const int tc = t < 0 ? 0 : (t >= L ? L - 1 : t); const bf16* r = proj + (size_t)tc * NIN + c;
        const float a0 = bf2f(r[0]), a1 = bf2f(r[512]), a2 = bf2f(r[1024]); d[0] = ok ? a0 : 0.f; d[1] = ok ? a1 : 0.f; d[2] = ok ? a2 : 0.f; };
    ld(t0 - 1, pv); ld(t0, cv);
    float zo[32], xo[32];
#pragma unroll
    for (int i = 0; i < 32; ++i) { ld(t0 + i + 1, nv);
        float u[3];
#pragma unroll
        for (int s = 0; s < 3; ++s) u[s] = bb[s] + pv[s] * w0[s] + cv[s] * w1[s] + nv[s] * w2[s];
        xo[i] = u[0]; zo[i] = u[2] * u[1];
#pragma unroll
        for (int s = 0; s < 3; ++s) { pv[s] = cv[s]; cv[s] = nv[s]; } }
#pragma unroll
    for (int i = 0; i < 4; ++i) { u32x4 w; w.x = pk2(zo[8 * i], zo[8 * i + 1]); w.y = pk2(zo[8 * i + 2], zo[8 * i + 3]); w.z = pk2(zo[8 * i + 4], zo[8 * i + 5]); w.w = pk2(zo[8 * i + 6], zo[8 * i + 7]); ((u32x4*)zt)[i] = w; }
#pragma unroll
    for (int i = 0; i < 4; ++i) { u32x4 w; w.x = pk2(xo[8 * i], xo[8 * i + 1]); w.y = pk2(xo[8 * i + 2], xo[8 * i + 3]); w.z = pk2(xo[8 * i + 4], xo[8 * i + 5]); w.w = pk2(xo[8 * i + 6], xo[8 * i + 7]); ((u32x4*)x0t)[i] = w; }
}

__device__ __forceinline__ void p2_filter_item(Frame& F, int item) {
    const int tid = (int)threadIdx.x;
    const bool prompt = item < 512; const int it = prompt ? item : item - 512;
    const int L = prompt ? LP : LS; const int cg = prompt ? (it >> 2) : it, pc = prompt ? (it & 3) : 0;
    const int c0 = cg * 8, j4 = pc * 2048 + tid * 4;
    const float* h2 = (const float*)(F.ws + (prompt ? WS_H2P : WS_H2S)); const float* w3 = F.in[13] + c0;
    float* kern = (float*)(F.ws + (prompt ? WS_KERNP : WS_KERNS));
    f32x4 acc[8];
#pragma unroll
    for (int c = 0; c < 8; ++c) acc[c] = (f32x4){0.f, 0.f, 0.f, 0.f};
#pragma unroll 8
    for (int k = 0; k < 64; ++k) { const f32x4 hv = *(const f32x4*)(h2 + (size_t)k * L + j4); const f32x4 wa = *(const f32x4*)(w3 + k * 1024), wb = *(const f32x4*)(w3 + k * 1024 + 4);
        acc[0] += hv * wa.x; acc[1] += hv * wa.y; acc[2] += hv * wa.z; acc[3] += hv * wa.w; acc[4] += hv * wb.x; acc[5] += hv * wb.y; acc[6] += hv * wb.z; acc[7] += hv * wb.w; }
    const float min_decay = -15.350567286626973f, max_decay = -3.0701134573253945f; const float rl = 1.0f / (float)(L - 1);
#pragma unroll
    for (int c = 0; c < 8; ++c) { const int ch = (c0 + c) & 511; const float delta = fabsf(min_decay + (float)ch * ((max_decay - min_decay) / 511.0f)); f32x4 o;
#pragma unroll
        for (int e = 0; e < 4; ++e) o[e] = acc[c][e] * expf(-((float)(j4 + e) * rl) * delta);
        *(f32x4*)(kern + (size_t)(c0 + c) * L + j4) = o; }
}

__device__ __forceinline__ s16x4 vtr(const unsigned char* p) { typedef short v4i16_t __attribute__((ext_vector_type(4)));
    return __builtin_bit_cast(s16x4, __builtin_amdgcn_ds_read_tr16_b64_v4i16((LAS v4i16_t*)p)); }
__device__ __forceinline__ unsigned cvtpk(float lo, float hi) { typedef float f2 __attribute__((ext_vector_type(2))); typedef __bf16 b2 __attribute__((ext_vector_type(2))); f2 v = {lo, hi}; b2 r = __builtin_convertvector(v, b2); return __builtin_bit_cast(unsigned, r); }
__device__ __forceinline__ float max3f(float a, float b, float c) { float r; asm("v_max3_f32 %0, %1, %2, %3" : "=v"(r) : "v"(a), "v"(b), "v"(c)); return r; }
typedef float f32x2a __attribute__((ext_vector_type(2)));
#ifndef ATT_SCHED
#define ATT_SCHED 1
#endif
#ifndef ATT_THR
#define ATT_THR 8.0f
#endif
#ifndef ATT_TRACK_LIMIT
#define ATT_TRACK_LIMIT 4.0f
#endif
template <bool LAST> __device__ __forceinline__ void attn_step(f32x16& p0, f32x16& p1, f32x16& q0, f32x16& q1, f32x16& o0, f32x16& o1, float& mrun, float& lsum, f32x16& negm, const bool track, const bf16x8 (&qr)[6],
        const unsigned char* lds, int t, int NT, const unsigned char* KV, int tid, int r32, int hi, int voff) {
    const int cur = t % 3, nxt = (t + 1) % 3, nn = (t + 2) % 3;
    u32x4 s0, s1, s2 = (u32x4){0u, 0u, 0u, 0u};
    if (!LAST) { const int tl = (t + 2 < NT) ? t + 2 : NT - 1; const u32x4* src = (const u32x4*)(KV + (size_t)tl * KVT_BYTES); s0 = src[tid]; s1 = src[tid + 512]; if (tid < 256) s2 = src[tid + 1024]; }
    const unsigned char* kb = lds + nxt * KVT_BYTES;
    const unsigned char* vb = lds + cur * KVT_BYTES + KT_BYTES + voff;
    bf16x8 kf[12];
    if (!LAST) {
#pragma unroll
        for (int d = 0; d < 6; ++d) { kf[2 * d] = *(const bf16x8*)(kb + ((2 * d + hi) * 64 + r32) * 16); kf[2 * d + 1] = *(const bf16x8*)(kb + ((2 * d + hi) * 64 + 32 + r32) * 16); }
    }
    s16x4 va[8], vc[8];
#pragma unroll
    for (int s = 0; s < 4; ++s) { va[2 * s] = vtr(vb + s * 1024); va[2 * s + 1] = vtr(vb + s * 1024 + 512); vc[2 * s] = vtr(vb + 4096 + s * 1024); vc[2 * s + 1] = vtr(vb + 4096 + s * 1024 + 512); }
    if (!LAST) {
        q0 = __builtin_amdgcn_mfma_f32_32x32x16_bf16(kf[0], qr[0], negm, 0, 0, 0); q1 = __builtin_amdgcn_mfma_f32_32x32x16_bf16(kf[1], qr[0], negm, 0, 0, 0);
#pragma unroll
        for (int d = 1; d < 6; ++d) { q0 = __builtin_amdgcn_mfma_f32_32x32x16_bf16(kf[2 * d], qr[d], q0, 0, 0, 0); q1 = __builtin_amdgcn_mfma_f32_32x32x16_bf16(kf[2 * d + 1], qr[d], q1, 0, 0, 0); }
    }
    if (track) {
        float mx = max3f(p0[0], p0[1], p1[0]);
#pragma unroll
        for (int r = 2; r < 16; r += 2) mx = max3f(mx, p0[r], p0[r + 1]);
#pragma unroll
        for (int r = 1; r < 15; r += 2) mx = max3f(mx, p1[r], p1[r + 1]);
        mx = fmaxf(mx, p1[15]);
        { auto rr = __builtin_amdgcn_permlane32_swap(__float_as_uint(mx), __float_as_uint(mx), false, false); mx = fmaxf(__uint_as_float(rr[0]), __uint_as_float(rr[1])); }
        if (__any(mx > ATT_THR)) {
            const float dl = fmaxf(mx, 0.f); mrun += dl; const float alpha = __builtin_amdgcn_exp2f(-dl); lsum *= alpha;
#pragma unroll
            for (int r = 0; r < 16; ++r) { p0[r] -= dl; p1[r] -= dl; o0[r] *= alpha; o1[r] *= alpha; negm[r] = -mrun; }
            if (!LAST) {
#pragma unroll
                for (int r = 0; r < 16; ++r) { q0[r] -= dl; q1[r] -= dl; }
            }
        }
    }
    float psa = 0.f, psb = 0.f;
#pragma unroll
    for (int r = 0; r < 16; ++r) { p0[r] = __builtin_amdgcn_exp2f(p0[r]); p1[r] = __builtin_amdgcn_exp2f(p1[r]); psa += p0[r]; psb += p1[r]; }
    lsum += (psa + psb);
    u32x4 pw[4];
#pragma unroll
    for (int s = 0; s < 4; ++s) { const int bse = 8 * (s & 1);
        if (s < 2) pw[s] = (u32x4){cvtpk(p0[bse], p0[bse + 1]), cvtpk(p0[bse + 2], p0[bse + 3]), cvtpk(p0[bse + 4], p0[bse + 5]), cvtpk(p0[bse + 6], p0[bse + 7])};
        else pw[s] = (u32x4){cvtpk(p1[bse], p1[bse + 1]), cvtpk(p1[bse + 2], p1[bse + 3]), cvtpk(p1[bse + 4], p1[bse + 5]), cvtpk(p1[bse + 6], p1[bse + 7])}; }
#if ATT_SCHED
    if (!LAST) {
#pragma unroll
        for (int i = 0; i < 12; ++i) { __builtin_amdgcn_sched_group_barrier(0x008, 1, 0); __builtin_amdgcn_sched_group_barrier(0x002, 12, 0); }
    }
#endif
#pragma unroll
    for (int s = 0; s < 4; ++s) {
        const s16x4 a0 = va[2 * s], a1 = va[2 * s + 1], c0 = vc[2 * s], c1 = vc[2 * s + 1];
        const bf16x8 v0 = (bf16x8){a0[0], a0[1], a0[2], a0[3], a1[0], a1[1], a1[2], a1[3]}, v1 = (bf16x8){c0[0], c0[1], c0[2], c0[3], c1[0], c1[1], c1[2], c1[3]};
        const bf16x8 pf = __builtin_bit_cast(bf16x8, pw[s]);
        o0 = __builtin_amdgcn_mfma_f32_32x32x16_bf16(v0, pf, o0, 0, 0, 0); o1 = __builtin_amdgcn_mfma_f32_32x32x16_bf16(v1, pf, o1, 0, 0, 0);
    }
    if (!LAST) { u32x4* dst = (u32x4*)(lds + nn * KVT_BYTES); dst[tid] = s0; dst[tid + 512] = s1; if (tid < 256) dst[tid + 1024] = s2; }
    __syncthreads();
}
__device__ __forceinline__ void attn_unit(Frame& F, bool prompt, int bh, int qb) {
    const int tid = ((int)threadIdx.x), lane = ((int)threadIdx.x & 63), wid = F.wave, r32 = lane & 31, hi = lane >> 5;
    const int L = prompt ? LP : LS, NT = L / 64;
    const bf16* Qg = (const bf16*)(F.ws + WS_A) + (prompt ? 0 : QS_OFF) + ((size_t)bh * L + qb * 256 + wid * 32 + r32) * QKD + hi * 8;
    const unsigned char* KV = F.ws + WS_C + (prompt ? 0 : KVS_OFF) + (size_t)bh * NT * KVT_BYTES;
    unsigned char* lds = F.lds;
    bf16x8 qr[6];
#pragma unroll
    for (int d = 0; d < 6; ++d) qr[d] = *(const bf16x8*)(Qg + d * 16);
    f32x16 o0 = (f32x16){}, o1 = (f32x16){}; float mrun = 0.f, lsum = 0.f;
    { const u32x4* src = (const u32x4*)KV; u32x4* dst = (u32x4*)lds;
#pragma unroll
      for (int j = 0; j < 2; ++j) { const u32x4 a = src[j * 1280 + tid], b = src[j * 1280 + tid + 512]; u32x4 c = (u32x4){0u, 0u, 0u, 0u}; if (tid < 256) c = src[j * 1280 + tid + 1024];
          dst[j * 1280 + tid] = a; dst[j * 1280 + tid + 512] = b; if (tid < 256) dst[j * 1280 + tid + 1024] = c; } }
    __syncthreads();
    const int voff = (4 * hi + ((lane & 15) >> 2)) * 64 + ((lane >> 4) & 1) * 32 + (lane & 3) * 8;
    f32x16 pa0 = (f32x16){}, pa1 = (f32x16){}, pb0, pb1;
#pragma unroll
    for (int d = 0; d < 6; ++d) {
        const bf16x8 k0 = *(const bf16x8*)(lds + ((2 * d + hi) * 64 + r32) * 16), k1 = *(const bf16x8*)(lds + ((2 * d + hi) * 64 + 32 + r32) * 16);
        pa0 = __builtin_amdgcn_mfma_f32_32x32x16_bf16(k0, qr[d], pa0, 0, 0, 0); pa1 = __builtin_amdgcn_mfma_f32_32x32x16_bf16(k1, qr[d], pa1, 0, 0, 0);
    }
    f32x16 negm;
    { float mx = fmaxf(pa0[0], pa1[0]);
#pragma unroll
      for (int r = 1; r < 16; ++r) mx = fmaxf(mx, fmaxf(pa0[r], pa1[r]));
      mx = fmaxf(mx, __shfl_xor(mx, 32)); mrun = mx;
#pragma unroll
      for (int r = 0; r < 16; ++r) { pa0[r] -= mx; pa1[r] -= mx; negm[r] = -mx; } }
    bool track;
    { const float* qnw = F.in[19]; const float* knw = F.in[20]; float gq = 0.f, gk = 0.f;
      for (int i = 0; i < QKD; ++i) { gq = fmaxf(gq, fabsf(qnw[i])); gk = fmaxf(gk, fabsf(knw[i])); }
      track = !(gq * gk < ATT_TRACK_LIMIT); }
    int t = 0;
    for (; t + 2 < NT; t += 2) {
        attn_step<false>(pa0, pa1, pb0, pb1, o0, o1, mrun, lsum, negm, track, qr, lds, t, NT, KV, tid, r32, hi, voff);
        attn_step<false>(pb0, pb1, pa0, pa1, o0, o1, mrun, lsum, negm, track, qr, lds, t + 1, NT, KV, tid, r32, hi, voff);
    }
    attn_step<false>(pa0, pa1, pb0, pb1, o0, o1, mrun, lsum, negm, track, qr, lds, t, NT, KV, tid, r32, hi, voff);
    attn_step<true>(pb0, pb1, pa0, pa1, o0, o1, mrun, lsum, negm, track, qr, lds, t + 1, NT, KV, tid, r32, hi, voff);
    lsum += __shfl_xor(lsum, 32);
    const float il = 1.0f / lsum;
    const int b = bh >> 3, h = bh & 7;
    const size_t mrow = (prompt ? 0 : (size_t)MP) + (size_t)b * L + qb * 256 + wid * 32 + r32;
    float* yo = (float*)(F.ws + WS_YMLA) + mrow * 512 + h * 64 + 4 * hi;
#pragma unroll
    for (int g = 0; g < 4; ++g) { *(f32x4*)(yo + 8 * g) = (f32x4){o0[4 * g] * il, o0[4 * g + 1] * il, o0[4 * g + 2] * il, o0[4 * g + 3] * il};
        *(f32x4*)(yo + 32 + 8 * g) = (f32x4){o1[4 * g] * il, o1[4 * g + 1] * il, o1[4 * g + 2] * il, o1[4 * g + 3] * il}; }
}

__device__ __forceinline__ float2 cmul(float2 a, float2 b) { return make_float2(ffms_s(a.x, b.x, fmul_s(a.y, b.y)), ffma_s(a.x, b.y, fmul_s(a.y, b.x))); }
__device__ __forceinline__ float2 cmulc(float2 a, float2 b) { return make_float2(ffma_s(a.x, b.x, fmul_s(a.y, b.y)), ffms_s(a.y, b.x, fmul_s(a.x, b.y))); }
__device__ __forceinline__ float2 cadd(float2 a, float2 b) { return make_float2(fadd_s(a.x, b.x), fadd_s(a.y, b.y)); }
__device__ __forceinline__ float2 csub(float2 a, float2 b) { return make_float2(fsub_s(a.x, b.x), fsub_s(a.y, b.y)); }
template <bool INV> __device__ __forceinline__ void bfly4(float2& x0, float2& x1, float2& x2, float2& x3, float rev, float one, float mone) {
    const float2 w1 = make_float2(__builtin_amdgcn_cosf(rev) * one, __builtin_amdgcn_sinf(rev) * mone); const float2 w2 = cmul(w1, w1), w3 = cmul(w2, w1);
    if (!INV) {
        const float2 a = cadd(x0, x2), bq = csub(x0, x2), c = cadd(x1, x3), d = csub(x1, x3);
        const float2 y1 = make_float2(fadd_s(bq.x, d.y), fsub_s(bq.y, d.x)), y3 = make_float2(fsub_s(bq.x, d.y), fadd_s(bq.y, d.x));
        x0 = cadd(a, c); x2 = cmul(csub(a, c), w2); x1 = cmul(y1, w1); x3 = cmul(y3, w3);
    } else {
        x1 = cmulc(x1, w1); x2 = cmulc(x2, w2); x3 = cmulc(x3, w3);
        const float2 a = cadd(x0, x2), bq = csub(x0, x2), c = cadd(x1, x3), d = csub(x1, x3);
        x0 = cadd(a, c); x2 = csub(a, c); x1 = make_float2(fsub_s(bq.x, d.y), fadd_s(bq.y, d.x)); x3 = make_float2(fadd_s(bq.x, d.y), fsub_s(bq.y, d.x));
    }
}
#define PHI(i) ((i) + ((i) >> 4))
#define PADN(n) ((n) + ((n) >> 4))
template <bool INV> __device__ __forceinline__ void fft_lds(float2* buf0, int N, int logN, const float2* tw, int tid, int nbuf = 1) {
    (void)tw;
    float one = 1.0f, mone = -1.0f; asm volatile("" : "+v"(one), "+v"(mone));
    const int nst = logN >> 1, npair = nst >> 1, odd = nst & 1;
    const int npass = npair + odd;
    for (int ps = 0; ps < npass; ++ps) {
        const int pi = INV ? (npass - 1 - ps) : ps;
        if (pi < npair) {
            const int lsA = logN - 2 - 4 * pi, lsB = lsA - 2;
            const int s = 1 << lsA, sp = 1 << lsB;
            const float rA = 1.0f / (float)(4 * s), rB = 1.0f / (float)s;
#pragma unroll 2
            for (int gg = tid; gg < nbuf * (N >> 4); gg += NTHR) {
                const int g = gg & ((N >> 4) - 1); float2* buf = buf0 + (size_t)(gg >> (logN - 4)) * PADN(N);
                const int n0 = g & (sp - 1), base = ((g >> lsB) << (lsA + 2)) + n0;
                float2 x[4][4];
#pragma unroll
                for (int a = 0; a < 4; ++a)
#pragma unroll
                    for (int b = 0; b < 4; ++b) x[a][b] = buf[PHI(base + a * sp + b * s)];
                if (!INV) {
#pragma unroll
                    for (int a = 0; a < 4; ++a) bfly4<false>(x[a][0], x[a][1], x[a][2], x[a][3], (float)(n0 + a * sp) * rA, one, mone);
#pragma unroll
                    for (int q = 0; q < 4; ++q) bfly4<false>(x[0][q], x[1][q], x[2][q], x[3][q], (float)n0 * rB, one, mone);
                } else {
#pragma unroll
                    for (int q = 0; q < 4; ++q) bfly4<true>(x[0][q], x[1][q], x[2][q], x[3][q], (float)n0 * rB, one, mone);
#pragma unroll
                    for (int a = 0; a < 4; ++a) bfly4<true>(x[a][0], x[a][1], x[a][2], x[a][3], (float)(n0 + a * sp) * rA, one, mone);
                }
#pragma unroll
                for (int a = 0; a < 4; ++a)
#pragma unroll
                    for (int b = 0; b < 4; ++b) buf[PHI(base + a * sp + b * s)] = x[a][b];
            }
        } else {
#pragma unroll 4
            for (int g = tid; g < nbuf * (N >> 2); g += NTHR) {
                float2* buf = buf0;
                const int base = g << 2;
                const int pb = PHI(base);
                float2 x0 = buf[pb], x1 = buf[pb + 1], x2 = buf[pb + 2], x3 = buf[pb + 3];
                bfly4<INV>(x0, x1, x2, x3, 0.0f, one, mone);
                buf[pb] = x0; buf[pb + 1] = x1; buf[pb + 2] = x2; buf[pb + 3] = x3;
            }
        }
        __syncthreads();
    }
}
template <bool prompt> __device__ __forceinline__ void fft_unit(Frame& F, int c) {
    const int tid = ((int)threadIdx.x); constexpr int L = prompt ? LP : LS, N = 2 * L, logN = prompt ? 14 : 12, nb = prompt ? BP : BS;
    float2* buf = (float2*)F.lds; float* w3l = (float*)(F.lds + LDSX_OFF);
    const float2* tw = (const float2*)(F.ws + WS_TW);
    float2* kspec = (float2*)(F.ws + WS_KSPEC) + (size_t)blockIdx.x * 16384;
    const float* h2 = (const float*)(F.ws + (prompt ? WS_H2P : WS_H2S));
    const bf16* zbase = (const bf16*)F.out + (prompt ? 0 : (size_t)MP * HYW); bf16* xbase = (bf16*)(F.out + (size_t)MT * HYW) + (prompt ? 0 : (size_t)MP * HYW);
    const float* w3 = F.in[13];
#ifndef FFT_REP
#define FFT_REP 1
#endif
#pragma unroll 1
    for (int rep = 0; rep < FFT_REP; ++rep) {
    const float bias = F.in[14][c];
    { const float* kf_ = (const float*)(F.ws + (prompt ? WS_KERNP : WS_KERNS)) + (size_t)c * L; const float* kb_ = kf_ + (size_t)512 * L;
#pragma unroll
      for (int i = 0; i < L / NTHR; ++i) { const int j = tid + i * NTHR; buf[PHI(j)] = make_float2(kf_[j] + (j == 0 ? bias : 0.f), 0.f); buf[PHI(N - 1 - j)] = make_float2(kb_[j], 0.f); } }
    __syncthreads();
    fft_lds<false>(buf, N, logN, tw, tid);
#pragma unroll 8
    for (int i = 0; i < N / NTHR; ++i) { const int p = tid + i * NTHR; kspec[p] = buf[PHI(p)]; }
    __syncthreads();
    const float invN = 1.0f / (float)N;
    constexpr int NBUF = prompt ? 1 : 4;
    for (int rd = 0; rd < (nb / 2) / NBUF; ++rd) {
#pragma unroll
        for (int k = 0; k < NBUF; ++k) { const int pr = rd * NBUF + k; float2* bk = buf + (size_t)k * PADN(N);
            const bf16* za = zbase + ((size_t)((2 * pr) * HYW + c) * L); const bf16* zb = zbase + ((size_t)((2 * pr + 1) * HYW + c) * L);
#pragma unroll
            for (int i = 0; i < L / NTHR; ++i) { const int t = tid + i * NTHR; bk[PHI(t)] = make_float2(bf2f(za[t]), bf2f(zb[t])); bk[PHI(L + t)] = make_float2(0.f, 0.f); } }
        __syncthreads();
        fft_lds<false>(buf, N, logN, tw, tid, NBUF);
#pragma unroll
        for (int k = 0; k < NBUF; ++k) { float2* bk = buf + (size_t)k * PADN(N);
#pragma unroll 8
            for (int i = 0; i < N / NTHR; ++i) { const int p = tid + i * NTHR; bk[PHI(p)] = cmul(bk[PHI(p)], kspec[p]); } }
        __syncthreads();
        fft_lds<true>(buf, N, logN, tw, tid, NBUF);
        if (rep == FFT_REP - 1) {
#pragma unroll
        for (int k = 0; k < NBUF; ++k) { const int pr = rd * NBUF + k; const float2* bk = buf + (size_t)k * PADN(N);
            bf16* xa = xbase + ((size_t)((2 * pr) * HYW + c) * L); bf16* xb = xbase + ((size_t)((2 * pr + 1) * HYW + c) * L);
#pragma unroll
            for (int i = 0; i < (L / NTHR < 8 ? L / NTHR : 8); ++i) { const int t = tid + i * NTHR; const float2 v = bk[PHI(t)];
                xa[t] = (bf16)f2bf(bf2f(xa[t]) * (v.x * invN)); xb[t] = (bf16)f2bf(bf2f(xb[t]) * (v.y * invN)); }
            if (L / NTHR > 8) {
#pragma unroll
            for (int i = 8; i < L / NTHR; ++i) { const int t = tid + i * NTHR; const float2 v = bk[PHI(t)];
                xa[t] = (bf16)f2bf(bf2f(xa[t]) * (v.x * invN)); xb[t] = (bf16)f2bf(bf2f(xb[t]) * (v.y * invN)); } } }
        }
        __syncthreads();
    }
    }
}
#undef PHI
#undef PADN

__device__ __forceinline__ void p4_unit(Frame& F, int unit) {
    const int tid = ((int)threadIdx.x), lane = ((int)threadIdx.x & 63), wid = F.wave; const int m0 = unit * 32;
    float* tile = (float*)F.lds;
    int b, t0, L; const bf16* yb = (const bf16*)(F.out + (size_t)MT * HYW);
    if (m0 < MP) { b = m0 / LP; t0 = m0 % LP; L = LP; } else { const int mm = m0 - MP; b = mm / LS; t0 = mm % LS; L = LS; yb += (size_t)MP * HYW; }
    { const u32x4* src = (const u32x4*)(yb + ((size_t)(b * HYW + tid) * L + t0));
#pragma unroll
      for (int i = 0; i < 4; ++i) { const u32x4 v = src[i]; const unsigned w[4] = {v.x, v.y, v.z, v.w};
#pragma unroll
          for (int e = 0; e < 4; ++e) { tile[(8 * i + 2 * e) * 512 + tid] = __uint_as_float(w[e] << 16); tile[(8 * i + 2 * e + 1) * 512 + tid] = __uint_as_float(w[e] & 0xffff0000u); } } }
    __syncthreads();
    bf16* mix = (bf16*)(F.ws + WS_MIX); const float* hw = F.in[21]; const float* mw = F.in[22]; const float* ym = (const float*)(F.ws + WS_YMLA);
#pragma unroll
    for (int i = 0; i < 4; ++i) { const int tk = wid * 4 + i; const size_t m = (size_t)m0 + tk;
        { const f32x4 a = *(const f32x4*)(tile + tk * 512 + lane * 8), c = *(const f32x4*)(tile + tk * 512 + lane * 8 + 4);
          float ss = (a.x * a.x + a.y * a.y) + (a.z * a.z + a.w * a.w) + (c.x * c.x + c.y * c.y) + (c.z * c.z + c.w * c.w); ss = wave_sum(ss);
          const float r = 1.0f / sqrtf(ss * (1.0f / 512.0f) + EPS); const f32x4 wa = *(const f32x4*)(hw + lane * 8), wc = *(const f32x4*)(hw + lane * 8 + 4);
          u32x4 w; w.x = pk2(a.x * r * wa.x, a.y * r * wa.y); w.y = pk2(a.z * r * wa.z, a.w * r * wa.w); w.z = pk2(c.x * r * wc.x, c.y * r * wc.y); w.w = pk2(c.z * r * wc.z, c.w * r * wc.w);
          *(u32x4*)(mix + m * 1024 + lane * 8) = w; }
        { const f32x4 a = *(const f32x4*)(ym + m * 512 + lane * 8), c = *(const f32x4*)(ym + m * 512 + lane * 8 + 4);
          float ss = (a.x * a.x + a.y * a.y) + (a.z * a.z + a.w * a.w) + (c.x * c.x + c.y * c.y) + (c.z * c.z + c.w * c.w); ss = wave_sum(ss);
          const float r = 1.0f / sqrtf(ss * (1.0f / 512.0f) + EPS); const f32x4 wa = *(const f32x4*)(mw + lane * 8), wc = *(const f32x4*)(mw + lane * 8 + 4);
          u32x4 w; w.x = pk2(a.x * r * wa.x, a.y * r * wa.y); w.y = pk2(a.z * r * wa.z, a.w * r * wa.w); w.z = pk2(c.x * r * wc.x, c.y * r * wc.y); w.w = pk2(c.z * r * wc.z, c.w * r * wc.w);
          *(u32x4*)(mix + m * 1024 + 512 + lane * 8) = w; } }
    __syncthreads();
}
#define XB_TMO      128
#define XB_XCNT(j)  (256  + 64 * (j))
#define XB_XSUB(j)  (1280 + 64 * (j))
#define XB_XGEN(j)  (2304 + 64 * (j))
#define XB_TOP      3328
#define XB_TOPGEN   3392
#define XCD_BAR_WORDS 3456
#define XB_SPIN_CAP (1u << 18)

__device__ __forceinline__ unsigned xb_ld(unsigned* p)              { return __hip_atomic_load(p, __ATOMIC_RELAXED, __HIP_MEMORY_SCOPE_AGENT); }
__device__ __forceinline__ unsigned xb_add(unsigned* p, unsigned v) { return __hip_atomic_fetch_add(p, v, __ATOMIC_RELAXED, __HIP_MEMORY_SCOPE_AGENT); }
__device__ __forceinline__ unsigned xb_xcc_id() { return (unsigned)__builtin_amdgcn_s_getreg((3 << 11) | 20) & 0xFu; }
#define XB_SPIN(cond, bar) do { unsigned _sp = 0; while (cond) { __builtin_amdgcn_s_sleep(1); \
    if ((++_sp & 255u) == 0u) { if (xb_ld(&(bar)[XB_TMO])) break; if (_sp > XB_SPIN_CAP) { atomicAdd(&(bar)[XB_TMO], 1u); break; } } } } while (0)

struct XcdBarrier {
    unsigned* bar; unsigned x;
    volatile LAS unsigned* st;
};

__device__ __forceinline__ XcdBarrier xcd_barrier_post(unsigned* bar, volatile LAS unsigned* st) {
    XcdBarrier b; b.bar = bar; b.x = xb_xcc_id(); b.st = st;
    if (threadIdx.x == 0) (void)xb_add(&bar[XB_XCNT(b.x)], 1u);
    return b;
}
__device__ __forceinline__ void xcd_barrier_complete(unsigned* bar, unsigned x, unsigned& nloc, unsigned& nx) {
    const unsigned G = gridDim.x * gridDim.y * gridDim.z;
    unsigned sum, cnt, mine, sp = 0u;
    for (;;) {
        sum = 0u; cnt = 0u; mine = 0u;
#pragma unroll
        for (unsigned j = 0; j < 16; ++j) { const unsigned c = xb_ld(&bar[XB_XCNT(j)]); sum += c; cnt += (c > 0u) ? 1u : 0u; mine = (j == x) ? c : mine; }
        if (sum == G) break;
        __builtin_amdgcn_s_sleep(1);
        if ((++sp & 255u) == 0u) { if (xb_ld(&bar[XB_TMO])) break; if (sp > XB_SPIN_CAP) { atomicAdd(&bar[XB_TMO], 1u); break; } }
    }
    nloc = mine > 0u ? mine : 1u; nx = cnt > 0u ? cnt : 1u;
}

__device__ __forceinline__ void xcd_barrier(const XcdBarrier& b) {
    asm volatile("s_waitcnt vmcnt(0)" ::: "memory");
    __syncthreads();
    if (threadIdx.x == 0) {
        unsigned* bar = b.bar;
        __builtin_amdgcn_s_waitcnt(0);
        unsigned nloc = b.st[0], nx = b.st[1];
        if (nloc == 0u) { xcd_barrier_complete(bar, b.x, nloc, nx); b.st[0] = nloc; b.st[1] = nx; }
        const unsigned old = xb_add(&bar[XB_XSUB(b.x)], 1u);
        const unsigned gen = old / nloc;
        if (old + 1u == (gen + 1u) * nloc) {
            __builtin_amdgcn_fence(__ATOMIC_RELEASE, "agent");
            asm volatile("s_waitcnt vmcnt(0)" ::: "memory");
            const unsigned og = xb_add(&bar[XB_TOP], 1u);
            const unsigned tg = og / nx;
            if (og + 1u == (tg + 1u) * nx) xb_add(&bar[XB_TOPGEN], 1u);
            else XB_SPIN(xb_ld(&bar[XB_TOPGEN]) == tg, bar);
            __builtin_amdgcn_fence(__ATOMIC_ACQUIRE, "agent");
            xb_add(&bar[XB_XGEN(b.x)], 1u);
            asm volatile("s_waitcnt vmcnt(0)" ::: "memory");
        } else {
            XB_SPIN(xb_ld(&bar[XB_XGEN(b.x)]) == gen, bar);
            __builtin_amdgcn_fence(__ATOMIC_ACQUIRE, "agent");
            asm volatile("s_waitcnt vmcnt(0)" ::: "memory");
        }
    }
    __syncthreads();
}
constexpr int N_PHASES = 12;
#ifndef SKIPMASK
#define SKIPMASK 0
#endif
__global__ void __launch_bounds__(NTHR, 2) mk_fwd(Args args) {
    extern __shared__ __attribute__((aligned(16))) unsigned char lds[];
    Frame F;
    F.lds = lds; F.wave = __builtin_amdgcn_readfirstlane((int)threadIdx.x >> 6);
    F.G = gridDim.x; { const int bx = blockIdx.x; F.vcu = (F.G % 8 == 0) ? (bx % 8) * (F.G / 8) + bx / 8 : bx; }
#pragma unroll
    for (int i = 0; i < 30; ++i) F.in[i] = args.in[i];
    F.out = args.out; F.ws = args.ws;
    unsigned char* ws = args.ws;
    LAS unsigned char* ldsl = (LAS unsigned char*)lds;
    for (int u = (int)threadIdx.x; u < (LDS_BYTES - LDSCTL_OFF) / 4; u += NTHR) ((LAS unsigned*)(ldsl + LDSCTL_OFF))[u] = 0u;
    __syncthreads();
    const int lo = args.ph_lo, hi = args.ph_hi;
    XcdBarrier bar; bar.bar = (unsigned*)(ws + WS_CTL) + CW_BAR; bar.x = 0; bar.st = nullptr;
#if MK_COOP && MK_XCDBAR
    bar = xcd_barrier_post((unsigned*)(ws + WS_CTL) + CW_BAR, (volatile LAS unsigned*)(ldsl + MISC_OFF) + 8);
#endif
#define IN(k) (lo <= (k) && (k) < hi)
#define BOTH(k) (IN(k) && IN((k) + 1))
#if MK_COOP
#if MK_XCDBAR
#ifndef BAR_REP
#define BAR_REP 1
#endif
#define GRID_BAR(k) do { if ((k) == 0) cg::this_grid().sync(); else { for (int br_ = 0; br_ < BAR_REP; ++br_) xcd_barrier(bar); } } while (0)
#else
#define GRID_BAR(k) cg::this_grid().sync()
#endif
#else
#define GRID_BAR(k) do { } while (0)
#endif
    bf16* xb = (bf16*)(ws + WS_A);
    float* rowss1 = (float*)(ws + WS_ROWSS1); float* rowssp = (float*)(ws + WS_ROWSSP);
    bf16* hmid = (bf16*)(ws + WS_HMID);

#ifndef P0_REP
#define P0_REP 1
#endif
    if (IN(0) && !(SKIPMASK >> 0 & 1)) {
#pragma unroll 1
        for (int rep = 0; rep < P0_REP; ++rep) p0_prologue(F); if (BOTH(0)) GRID_BAR(0); }
    if (IN(1) && !(SKIPMASK >> 1 & 1)) {
        pg8::Gemm g{xb, (const bf16*)(ws + WS_WIN), MT, NIN, 1024}; pg8::StaticOrder S; S.init(MT, NIN, F.G, (int)blockIdx.x);
        pg8::EpiScaleBf16 E{(bf16*)(ws + WS_B), NIN, (const float*)(ws + WS_RSTD0)};
#ifndef P1_REP
#define P1_REP 1
#endif
#pragma unroll 1
        for (int rep = 0; rep < P1_REP; ++rep) pg8::gemm_phase<pg8::EpiScaleBf16, pg8::StaticOrder, true, true>(ldsl, g, S, E);
        if (BOTH(1)) GRID_BAR(1);
    }
    if (IN(2) && !(SKIPMASK >> 2 & 1)) {
#ifndef P2A_REP
#define P2A_REP 1
#endif
#ifndef P2B_REP
#define P2B_REP 1
#endif
#pragma unroll 1
        for (int rep = 0; rep < P2A_REP; ++rep) for (int t = F.vcu; t < MT / 192; t += F.G) p2_mla_wg(F, t);
#pragma unroll 1
        for (int rep = 0; rep < P2B_REP; ++rep) for (int u = F.vcu; u < MT / 32; u += F.G) p2_hyena_front(F, u);
        for (int u = F.vcu; u < 640; u += F.G) p2_filter_item(F, u);
        if (BOTH(2)) GRID_BAR(2);
    }
    if (IN(3) && !(SKIPMASK >> 3 & 1)) {
#ifndef ATTN_REP
#define ATTN_REP 1
#endif
#ifndef FFT_REP
#define FFT_REP 1
#endif
#pragma unroll 1
        for (int rep = 0; rep < ATTN_REP; ++rep) {
        for (int u = F.vcu; u < 1024; u += F.G) attn_unit(F, true, u >> 5, u & 31);
        for (int u = F.vcu; u < 512; u += F.G) attn_unit(F, false, u >> 3, u & 7);
        }
        for (int c = F.vcu; c < HYW; c += F.G) fft_unit<true>(F, c);
        for (int c = F.vcu; c < HYW; c += F.G) fft_unit<false>(F, c);
        if (BOTH(3)) GRID_BAR(3);
    }
    if (IN(4) && !(SKIPMASK >> 4 & 1)) {
#ifndef P4_REP
#define P4_REP 1
#endif
#pragma unroll 1
        for (int rep = 0; rep < P4_REP; ++rep) for (int u = F.vcu; u < MT / 32; u += F.G) p4_unit(F, u);
        if (BOTH(4)) GRID_BAR(4);
    }
    if (IN(5) && !(SKIPMASK >> 5 & 1)) {
        pg8::Gemm g{(const bf16*)(ws + WS_MIX), (const bf16*)(ws + WS_WOUT), MT, 1024, 1024}; pg8::StaticOrder S; S.init(MT, 1024, F.G, (int)blockIdx.x);
        pg8::EpiResBf16 E{args.in[0], args.in[1], MP, nullptr, xb, rowss1, 0};
        pg8::gemm_phase<pg8::EpiResBf16, pg8::StaticOrder, true, true>(ldsl, g, S, E);
        if (BOTH(5)) GRID_BAR(5);
    }
    if (IN(6) && !(SKIPMASK >> 6 & 1)) {
        pg8::Gemm g{xb, (const bf16*)(ws + WS_W1), MP, DFF, 1024}; pg8::StaticOrder S; S.init(MP, DFF, F.G, (int)blockIdx.x);
        pg8::EpiRelu2Bf16 E{hmid, DFF, rowss1, 0};
#ifndef P6_REP
#define P6_REP 1
#endif
#pragma unroll 1
        for (int rep = 0; rep < P6_REP; ++rep) pg8::gemm_phase<pg8::EpiRelu2Bf16, pg8::StaticOrder, true, true>(ldsl, g, S, E);
        if (BOTH(6)) GRID_BAR(6);
    }
    if (IN(7) && !(SKIPMASK >> 7 & 1)) {
        pg8::Gemm g{hmid, (const bf16*)(ws + WS_W2), MP, 1024, DFF}; pg8::StaticOrder S; S.init(MP, 1024, F.G, (int)blockIdx.x);
        pg8::EpiResBf16 E{nullptr, nullptr, 0, xb, xb, nullptr, 0};
        pg8::gemm_phase<pg8::EpiResBf16, pg8::StaticOrder, true, true>(ldsl, g, S, E);
        if (BOTH(7)) GRID_BAR(7);
    }
    if (IN(8) && !(SKIPMASK >> 8 & 1)) {
        pg8::Gemm g{xb + (size_t)MP * 1024, (const bf16*)(ws + WS_W1), MS, DFF, 1024}; pg8::StaticOrder S; S.init(MS, DFF, F.G, (int)blockIdx.x);
        pg8::EpiRelu2Bf16 E{hmid, DFF, rowss1, MP};
        pg8::gemm_phase<pg8::EpiRelu2Bf16, pg8::StaticOrder, true, true>(ldsl, g, S, E);
        if (BOTH(8)) GRID_BAR(8);
    }
    if (IN(9) && !(SKIPMASK >> 9 & 1)) {
        pg8::Gemm g{hmid, (const bf16*)(ws + WS_W2), MS, 1024, DFF}; pg8::StaticOrder S; S.init(MS, 1024, F.G, (int)blockIdx.x);
        pg8::EpiResBf16 E{nullptr, nullptr, 0, xb, xb, nullptr, MP};
        pg8::gemm_phase<pg8::EpiResBf16, pg8::StaticOrder, true, true>(ldsl, g, S, E);
        if (BOTH(9)) GRID_BAR(9);
    }
    if (IN(10) && !(SKIPMASK >> 10 & 1)) {
        pg8::Gemm g{(const bf16*)(ws + WS_PB), (const bf16*)(ws + WS_WPP), MT, 1024, PLE}; pg8::StaticOrder S; S.init(MT, 1024, F.G, (int)blockIdx.x);
        pg8::EpiBf16Ss E{(bf16*)(ws + WS_PP), 1024, rowssp};
        pg8::gemm_phase<pg8::EpiBf16Ss, pg8::StaticOrder, true, true>(ldsl, g, S, E);
        if (BOTH(10)) GRID_BAR(10);
    }
    if (IN(11) && !(SKIPMASK >> 11 & 1)) {
        pg8::Gemm g{xb, (const bf16*)(ws + WS_WG), MT, 1024, 1024}; pg8::StaticOrder S; S.init(MT, 1024, F.G, (int)blockIdx.x);
        pg8::EpiFinal E{args.out, xb, (const bf16*)(ws + WS_PP), rowssp, args.in[29]};
        pg8::gemm_phase<pg8::EpiFinal, pg8::StaticOrder, true, true>(ldsl, g, S, E);
    }
#undef IN
#undef BOTH
}

extern "C" void kernel_launch(void* const* d_in, const int* in_sizes, int n_in, void* d_out, int out_size, void* d_ws, size_t ws_size, hipStream_t stream) {
    static int grid = 0;
    if (grid == 0) {
        if (n_in != 30 || out_size != MT * DM || ws_size < WS_END) { fprintf(stderr, "kernel_launch: unexpected shapes (n_in %d out %d ws %zu)\n", n_in, out_size, ws_size); grid = -1; return; }
        int dev = 0, cus = 0, per_cu = 0;
        if (hipGetDevice(&dev) != hipSuccess || hipDeviceGetAttribute(&cus, hipDeviceAttributeMultiprocessorCount, dev) != hipSuccess) { grid = -1; return; }
        if (hipFuncSetAttribute((const void*)mk_fwd, hipFuncAttributeMaxDynamicSharedMemorySize, LDS_BYTES) != hipSuccess) { fprintf(stderr, "kernel_launch: hipFuncSetAttribute failed\n"); grid = -1; return; }
        if (hipOccupancyMaxActiveBlocksPerMultiprocessor(&per_cu, (const void*)mk_fwd, NTHR, LDS_BYTES) != hipSuccess || per_cu < 1) fprintf(stderr, "kernel_launch: occupancy query says %d\n", per_cu);
        (void)hipGetLastError();
        grid = cus;
    }
    if (grid < 0) return;
    (void)hipMemsetAsync((char*)d_ws + WS_CTL, 0, CTL_ZERO_BYTES, stream);
    Args a{};
    for (int i = 0; i < 30; ++i) a.in[i] = (const float*)d_in[i];
    a.out = (float*)d_out; a.ws = (unsigned char*)d_ws;
#if MK_COOP
    a.ph_lo = 0; a.ph_hi = N_PHASES;
    void* kargs[] = {&a};
    hipError_t e = hipLaunchCooperativeKernel((const void*)mk_fwd, dim3(grid), dim3(NTHR), kargs, LDS_BYTES, stream);
    if (e != hipSuccess) fprintf(stderr, "kernel_launch: cooperative launch failed: %s (grid %d)\n", hipGetErrorString(e), grid);
#else
    for (int p = 0; p < N_PHASES; ++p) { a.ph_lo = p; a.ph_hi = p + 1; hipLaunchKernelGGL(mk_fwd, dim3(grid), dim3(NTHR), LDS_BYTES, stream, a); }
#endif
}
```
